# Optimizing an MI355X kernel written in HIP

```python
import jax, jax.numpy as jnp
from jax import lax
import numpy as np

D_MODEL = 1024
BATCH = 8
SEQ = 2048
DEPTH = 4

N_A = DEPTH // 2
N_B = DEPTH - N_A
D_RNN = D_MODEL
LRU_BLOCK_W = 256
LRU_BLOCKS = D_RNN // LRU_BLOCK_W
CONV_W = 4
LRU_C = 8.0
N_HEADS = 16
HEAD_DIM = D_MODEL // N_HEADS
Q_BLOCK = 128
D_FF = ((8 * D_MODEL + 3 * 256 - 1) // (3 * 256)) * 256
EPS = 1e-6

kernel_name = "hawk_fox_yoco_hybrid"


def rmsnorm(x, g):
    xf = x.astype(jnp.float32)
    y = xf * lax.rsqrt(jnp.mean(xf * xf, axis=-1, keepdims=True) + EPS)
    return (y * g.astype(jnp.float32)).astype(x.dtype)


def swiglu(x, w_in, w_out):
    gate, up = jnp.split(x @ w_in, 2, axis=-1)
    return (jax.nn.silu(gate) * up) @ w_out


def causal_depthwise_conv(x, w, b):
    S = x.shape[1]
    xp = jnp.pad(x, ((0, 0), (CONV_W - 1, 0), (0, 0)))
    out = b
    for tap in range(CONV_W):
        out = out + xp[:, tap:tap + S] * w[tap]
    return out


def _lin_rec_combine(left, right):
    a1, b1 = left
    a2, b2 = right
    return a1 * a2, a2 * b1 + b2


def rg_lru(x, w_gates, b_gates, lru_param):
    B, S, _ = x.shape
    xb = x.reshape(B, S, LRU_BLOCKS, LRU_BLOCK_W)
    g = (jnp.einsum('bsnw,nwv->bsnv', xb, w_gates) + b_gates).astype(jnp.float32)
    gate_i = jax.nn.sigmoid(g[..., :LRU_BLOCK_W])
    gate_r = jax.nn.sigmoid(g[..., LRU_BLOCK_W:])
    log_a = -LRU_C * gate_r * jax.nn.softplus(-lru_param.astype(jnp.float32).reshape(LRU_BLOCKS, LRU_BLOCK_W))
    a = jnp.exp(log_a)
    mult = jnp.sqrt(-jnp.expm1(2.0 * log_a))
    u = xb.astype(jnp.float32) * gate_i * mult
    a = a.reshape(B, S, D_RNN)
    u = u.reshape(B, S, D_RNN)
    _, h = lax.associative_scan(_lin_rec_combine, (a, u), axis=1)
    return h.astype(x.dtype)


def recurrent_mixer(xn, w_in, conv_w, conv_b, w_gates, b_gates, lru_param, w_out):
    proj = xn @ w_in
    gate_branch, rec = proj[..., :D_RNN], proj[..., D_RNN:]
    rec = causal_depthwise_conv(rec, conv_w, conv_b)
    h = rg_lru(rec, w_gates, b_gates, lru_param)
    return (jax.nn.gelu(gate_branch) * h) @ w_out


def shared_kv_forget(xs, norm_kv, w_kvf, b_forget):
    B, S, _ = xs.shape
    p = rmsnorm(xs, norm_kv) @ w_kvf
    k = p[..., :D_MODEL].reshape(B, S, N_HEADS, HEAD_DIM).transpose(0, 2, 1, 3)
    v = p[..., D_MODEL:2 * D_MODEL].reshape(B, S, N_HEADS, HEAD_DIM).transpose(0, 2, 1, 3)
    f_logit = (p[..., 2 * D_MODEL:] + b_forget).astype(jnp.float32)
    c = jnp.cumsum(jax.nn.log_sigmoid(f_logit), axis=1).transpose(0, 2, 1)
    return k, v, c


def forgetting_attention(xn, w_q, w_o, k, v, c):
    B, S, _ = xn.shape
    q = (xn @ w_q).reshape(B, S, N_HEADS, HEAD_DIM).transpose(0, 2, 1, 3)
    scale = HEAD_DIM ** -0.5
    outs = []
    for blk in range(S // Q_BLOCK):
        q0 = blk * Q_BLOCK
        q1 = q0 + Q_BLOCK
        s = jnp.einsum('bhqd,bhkd->bhqk', q[:, :, q0:q1], k[:, :, :q1],
                       preferred_element_type=jnp.float32) * scale
        s = s + c[:, :, q0:q1, None] - c[:, :, None, :q1]
        mask = (q0 + jnp.arange(Q_BLOCK))[:, None] >= jnp.arange(q1)[None, :]
        s = jnp.where(mask, s, -jnp.inf)
        p = jax.nn.softmax(s, axis=-1)
        outs.append(jnp.einsum('bhqk,bhkd->bhqd', p.astype(v.dtype), v[:, :, :q1]))
    o = jnp.concatenate(outs, axis=2).transpose(0, 2, 1, 3).reshape(B, S, D_MODEL)
    return o @ w_o


def setup_inputs(seed: int = 0) -> dict:
    key = jax.random.key(seed)
    ks = jax.random.split(key, 20)
    f32 = jnp.float32
    nrm = lambda k, shape, fan_in: jax.random.normal(k, shape, f32) * (fan_in ** -0.5)
    gain = lambda k, shape: 1.0 + 0.01 * jax.random.normal(k, shape, f32)

    x = jax.random.normal(ks[0], (BATCH, SEQ, D_MODEL), f32)
    norm_mix = gain(ks[1], (DEPTH, D_MODEL))
    norm_ffn = gain(ks[2], (DEPTH, D_MODEL))
    w_ffn_in = nrm(ks[3], (DEPTH, D_MODEL, 2 * D_FF), D_MODEL)
    w_ffn_out = nrm(ks[4], (DEPTH, D_FF, D_MODEL), D_FF)

    w_rec_in = nrm(ks[5], (N_A, D_MODEL, 2 * D_RNN), D_MODEL)
    conv_w = nrm(ks[6], (N_A, CONV_W, D_RNN), CONV_W)
    conv_b = 0.01 * jax.random.normal(ks[7], (N_A, D_RNN), f32)
    w_lru_gates = nrm(ks[8], (N_A, LRU_BLOCKS, LRU_BLOCK_W, 2 * LRU_BLOCK_W), LRU_BLOCK_W)
    b_lru_gates = 0.01 * jax.random.normal(ks[9], (N_A, LRU_BLOCKS, 2 * LRU_BLOCK_W), f32)
    u = jax.random.uniform(ks[10], (N_A, D_RNN), f32, 0.9, 0.999)
    s = u ** (1.0 / LRU_C)
    lru_param = jnp.log(s) - jnp.log1p(-s)
    w_rec_out = nrm(ks[11], (N_A, D_RNN, D_MODEL), D_RNN)

    norm_kv = gain(ks[12], (D_MODEL,))
    w_kvf = nrm(ks[13], (D_MODEL, 2 * D_MODEL + N_HEADS), D_MODEL)
    b_forget = jnp.linspace(1.0, 5.0, N_HEADS, dtype=f32) + 0.1 * jax.random.normal(ks[14], (N_HEADS,), f32)
    w_q = nrm(ks[15], (N_B, D_MODEL, D_MODEL), D_MODEL)
    w_o = nrm(ks[16], (N_B, D_MODEL, D_MODEL), D_MODEL)
    norm_final = gain(ks[17], (D_MODEL,))
    return {"x": x, "norm_mix": norm_mix, "norm_ffn": norm_ffn, "w_ffn_in": w_ffn_in,
            "w_ffn_out": w_ffn_out, "w_rec_in": w_rec_in, "conv_w": conv_w, "conv_b": conv_b,
            "w_lru_gates": w_lru_gates, "b_lru_gates": b_lru_gates, "lru_param": lru_param,
            "w_rec_out": w_rec_out, "norm_kv": norm_kv, "w_kvf": w_kvf, "b_forget": b_forget,
            "w_q": w_q, "w_o": w_o, "norm_final": norm_final}


def reference(x, norm_mix, norm_ffn, w_ffn_in, w_ffn_out, w_rec_in, conv_w, conv_b,
              w_lru_gates, b_lru_gates, lru_param, w_rec_out, norm_kv, w_kvf, b_forget,
              w_q, w_o, norm_final):
    h = x
    k = v = c = None
    for layer in range(DEPTH):
        xn = rmsnorm(h, norm_mix[layer])
        if layer < N_A:
            i = layer
            mix = recurrent_mixer(xn, w_rec_in[i], conv_w[i], conv_b[i], w_lru_gates[i],
                                  b_lru_gates[i], lru_param[i], w_rec_out[i])
        else:
            if layer == N_A:
                k, v, c = shared_kv_forget(h, norm_kv, w_kvf, b_forget)
            j = layer - N_A
            mix = forgetting_attention(xn, w_q[j], w_o[j], k, v, c)
        h = h + mix
        h = h + swiglu(rmsnorm(h, norm_ffn[layer]), w_ffn_in[layer], w_ffn_out[layer])
    return rmsnorm(h, norm_final)
```

```cpp
#include <hip/hip_runtime.h>
#include <hip/hip_cooperative_groups.h>
#include <cstdio>
#include <cstdint>
namespace cg = cooperative_groups;
namespace pg8 {
#define PG8_LAS __attribute__((address_space(3)))
typedef unsigned short bf16_t;
typedef short bf16x8 __attribute__((ext_vector_type(8)));
typedef float f32x4 __attribute__((ext_vector_type(4)));
typedef unsigned u32x4 __attribute__((ext_vector_type(4)));
constexpr int BM = 256, BK = 64, HALF = 128, HTB = HALF * BK * 2  , STAGE_BYTES = 8 * HTB, NXCD = 8, WGM = 8;

__host__ __device__ __forceinline__ int lds_byte(int r, int c) { const int st = (r >> 4) * 2 + (c >> 5), rr = r & 15, cc = c & 31, ob = rr * 64 + cc * 2; return st * 1024 + (ob ^ (((ob >> 9) & 1) << 5)); }
__host__ __device__ __forceinline__ void stage_rc(int b, int& R, int& C) { const int st = b / 1024, sb = b % 1024, swz = sb ^ (((sb >> 9) & 1) << 5); R = (st >> 1) * 16 + swz / 64; C = (st & 1) * 32 + (swz % 64) / 2; }
__host__ __device__ __forceinline__ int perm32(int rho) { const int n = rho >> 4, i = rho & 15; return 8 * (i >> 2) + 4 * n + (i & 3); }

struct Unit { int pm, pn, idx; };
struct Gemm { const bf16_t* A; const bf16_t* Bt; int M, N, K; };

struct StaticOrder {
    int nM, nN, nwg, G, c;
    __host__ __device__ void init(int M, int N, int G_, int c_) { nM = M / BM; nN = N / BM; nwg = nM * nN; G = G_; c = c_; }
    __host__ __device__ bool next(int i, Unit& u) const {
        const long L = (long)i * G + c; if (L >= nwg) return false;
        int wgid = (int)L; { const int q = nwg / NXCD, r = nwg % NXCD, xcd = wgid % NXCD, off = wgid / NXCD; wgid = (xcd < r ? xcd * (q + 1) : r * (q + 1) + (xcd - r) * q) + off; }
        const int nig = WGM * nN, gid = wgid / nig, fm = gid * WGM, gsz = (nM - fm) < WGM ? (nM - fm) : WGM;
        u.pm = fm + ((wgid % nig) % gsz); u.pn = (wgid % nig) / gsz; return true;
    }
    __device__ __forceinline__ void a_ready(const Unit&) const {}
    __device__ __forceinline__ void done(const Unit&) const {}
    __device__ __forceinline__ void pre(int) const {}
};

__device__ __forceinline__ unsigned cvt_pk_bf16(float lo, float hi) { unsigned r; asm volatile("v_cvt_pk_bf16_f32 %0, %1, %2" : "=v"(r) : "v"(lo), "v"(hi)); return r; }
typedef float f32x2 __attribute__((ext_vector_type(2)));
template <class Epi, class Sched, bool ALIGN_EPI = false, bool SP2 = false>
__device__ __forceinline__ void gemm_phase(PG8_LAS unsigned char* lds, const Gemm g, const Sched& S, const Epi& E) {
    int tid_raw = threadIdx.x; asm volatile("" : "+v"(tid_raw));
    const int tid = tid_raw, wid = __builtin_amdgcn_readfirstlane(tid >> 6), lane = tid & 63, wr = wid >> 2, wc = wid & 3, fr = lane & 15, fq = lane >> 4;
    const int K = g.K, nt = K / BK;
    unsigned voffA[2], voffB[2];
#pragma unroll
    for (int i = 0; i < 2; ++i) { int R, C; stage_rc(tid * 16 + i * 8192, R, C); const int Rb = Epi::PERM ? ((R & ~31) + perm32(R & 31)) : R;
        voffA[i] = (unsigned)(R * K + C) * 2u; voffB[i] = (unsigned)(Rb * K + C) * 2u; }
    const size_t kstep = (size_t)(BK * 2);
    const size_t hstep = (size_t)HALF * K * 2;
    const size_t tstep = 2 * hstep;
    const unsigned ldsw = (unsigned)wid * 1024u;
    const int aoff = lds_byte(wr * 64 + fr, fq * 8), boff = lds_byte(wc * 32 + fr, fq * 8);
#define PG8_SA(b, h) (((b) * 2 + (h)) * HTB)
#define PG8_SB(b, h) ((4 + (b) * 2 + (h)) * HTB)
#define PG8_STAGE(bufoff, gbase, voff) do { _Pragma("unroll") for (int _i = 0; _i < 2; ++_i) \
        __builtin_amdgcn_global_load_lds((const unsigned*)((const char*)(gbase) + (voff)[_i]), (PG8_LAS unsigned*)(lds + (bufoff) + ldsw + _i * 8192), 16, 0, 0); } while (0)
#define PG8_LDA(dst, b, h) do { _Pragma("unroll") for (int m = 0; m < 4; ++m) _Pragma("unroll") for (int k = 0; k < 2; ++k) dst[m][k] = *(const PG8_LAS bf16x8*)(lds + PG8_SA(b, h) + aoff + m * 2048 + k * 1024); } while (0)
#define PG8_LDB(dst, b, h) do { _Pragma("unroll") for (int n = 0; n < 2; ++n) _Pragma("unroll") for (int k = 0; k < 2; ++k) dst[n][k] = *(const PG8_LAS bf16x8*)(lds + PG8_SB(b, h) + boff + n * 2048 + k * 1024); } while (0)
#define PG8_MMA(ai, bj, At, Bt) do { __builtin_amdgcn_s_setprio(1); _Pragma("unroll") for (int m = 0; m < 4; ++m) _Pragma("unroll") for (int n = 0; n < 2; ++n) _Pragma("unroll") for (int k = 0; k < 2; ++k) \
        acc[ai][bj][m][n] = __builtin_amdgcn_mfma_f32_16x16x32_bf16(Bt[n][k], At[m][k], acc[ai][bj][m][n], 0, 0, 0); __builtin_amdgcn_s_setprio(0); } while (0)
#define PG8_WAIT_V(n) asm volatile("s_waitcnt vmcnt(" #n ")" ::: "memory")
#define PG8_WAIT_L(n) asm volatile("s_waitcnt lgkmcnt(" #n ")" ::: "memory")
#define PG8_BAR __builtin_amdgcn_s_barrier()
#define PG8_SCHED __builtin_amdgcn_sched_barrier(0)
    Unit cur, nxt; int ui = 0;
    if (!S.next(0, cur)) return;
    f32x4 acc[2][2][4][2];
#pragma unroll
    for (int a = 0; a < 2; ++a)
#pragma unroll
        for (int b = 0; b < 2; ++b)
#pragma unroll
            for (int m = 0; m < 4; ++m)
#pragma unroll
                for (int n = 0; n < 2; ++n) acc[a][b][m][n] = (f32x4){0.f, 0.f, 0.f, 0.f};
    bf16x8 At[4][2], B0[2][2], B1[2][2];
    const char* cA = (const char*)g.A + (size_t)cur.pm * tstep; const char* cB = (const char*)g.Bt + (size_t)cur.pn * tstep;
    S.a_ready(cur);
    if constexpr (SP2) {
        PG8_STAGE(PG8_SB(0, 0), cB, voffB); PG8_STAGE(PG8_SB(0, 1), cB + hstep, voffB); PG8_STAGE(PG8_SA(0, 0), cA, voffA); PG8_STAGE(PG8_SA(0, 1), cA + hstep, voffA);
        S.pre(tid);
        if (wr == 1) PG8_BAR;
        PG8_WAIT_V(2); PG8_BAR;
        PG8_STAGE(PG8_SB(1, 0), cB + kstep, voffB); PG8_STAGE(PG8_SA(1, 0), cA + kstep, voffA); PG8_STAGE(PG8_SB(1, 1), cB + hstep + kstep, voffB);
        PG8_WAIT_V(6); PG8_BAR;
    } else {
        PG8_STAGE(PG8_SB(0, 0), cB, voffB); PG8_STAGE(PG8_SA(0, 0), cA, voffA); PG8_STAGE(PG8_SB(0, 1), cB + hstep, voffB); PG8_STAGE(PG8_SA(0, 1), cA + hstep, voffA);
        if (wr == 1) PG8_BAR;
        PG8_WAIT_V(4); PG8_BAR;
        PG8_STAGE(PG8_SB(1, 0), cB + kstep, voffB); PG8_STAGE(PG8_SA(1, 0), cA + kstep, voffA); PG8_STAGE(PG8_SB(1, 1), cB + hstep + kstep, voffB);
        PG8_WAIT_V(6); PG8_BAR;
    }
    for (;;) {
        const bool has_next = S.next(ui + 1, nxt);
        const char* nA = has_next ? (const char*)g.A + (size_t)nxt.pm * tstep : cA; const char* nB = has_next ? (const char*)g.Bt + (size_t)nxt.pn * tstep : cB;
        for (int t = 0; t < nt; t += 2) {
            const bool last = (t == nt - 2);
            const char* a1 = cA + (size_t)(t + 1) * kstep;
            const char* a2 = last ? nA : cA + (size_t)(t + 2) * kstep; const char* b2 = last ? nB : cB + (size_t)(t + 2) * kstep;
            const char* a3 = a2 + kstep; const char* b3 = b2 + kstep;
            if (last && has_next) S.a_ready(nxt);
            if constexpr (SP2) {
            PG8_LDB(B0, 0, 0); PG8_LDB(B1, 0, 1); PG8_SCHED; PG8_LDA(At, 0, 0); PG8_STAGE(PG8_SA(1, 1), a1 + hstep, voffA);
            PG8_WAIT_V(8); PG8_WAIT_L(0); PG8_BAR; PG8_MMA(0, 0, At, B0); PG8_MMA(0, 1, At, B1); PG8_BAR; PG8_SCHED;
            PG8_LDA(At, 0, 1); PG8_STAGE(PG8_SB(0, 0), b2, voffB); PG8_STAGE(PG8_SB(0, 1), b2 + hstep, voffB); PG8_STAGE(PG8_SA(0, 0), a2, voffA);
            PG8_WAIT_V(8); PG8_WAIT_L(0); PG8_BAR; PG8_MMA(1, 0, At, B0); PG8_MMA(1, 1, At, B1); PG8_BAR; PG8_SCHED;
            PG8_LDB(B0, 1, 0); PG8_LDB(B1, 1, 1); PG8_SCHED; PG8_LDA(At, 1, 0); PG8_STAGE(PG8_SA(0, 1), a2 + hstep, voffA);
            PG8_WAIT_V(8); PG8_WAIT_L(0); PG8_BAR; PG8_MMA(0, 0, At, B0); PG8_MMA(0, 1, At, B1); PG8_BAR; PG8_SCHED;
            PG8_LDA(At, 1, 1); PG8_STAGE(PG8_SB(1, 0), b3, voffB); PG8_STAGE(PG8_SB(1, 1), b3 + hstep, voffB); PG8_STAGE(PG8_SA(1, 0), a3, voffA);
            PG8_WAIT_V(8); PG8_WAIT_L(0); PG8_BAR; PG8_MMA(1, 0, At, B0); PG8_MMA(1, 1, At, B1); PG8_BAR; PG8_SCHED;
            } else {
            PG8_LDB(B0, 0, 0); PG8_SCHED; PG8_LDA(At, 0, 0); PG8_STAGE(PG8_SA(1, 1), a1 + hstep, voffA);
            PG8_WAIT_L(8); PG8_BAR; PG8_WAIT_L(0); PG8_MMA(0, 0, At, B0); PG8_BAR; PG8_SCHED;
            PG8_LDB(B1, 0, 1); PG8_STAGE(PG8_SB(0, 0), b2, voffB);
            PG8_BAR; PG8_WAIT_L(0); PG8_MMA(0, 1, At, B1); PG8_BAR;
            PG8_LDA(At, 0, 1); PG8_STAGE(PG8_SA(0, 0), a2, voffA);
            PG8_BAR; PG8_WAIT_L(0); PG8_MMA(1, 0, At, B0); PG8_BAR; PG8_SCHED;
            PG8_STAGE(PG8_SB(0, 1), b2 + hstep, voffB);
            PG8_WAIT_V(6); PG8_BAR; PG8_MMA(1, 1, At, B1); PG8_BAR;
            PG8_LDB(B0, 1, 0); PG8_SCHED; PG8_LDA(At, 1, 0); PG8_STAGE(PG8_SA(0, 1), a2 + hstep, voffA);
            PG8_WAIT_L(8); PG8_BAR; PG8_WAIT_L(0); PG8_MMA(0, 0, At, B0); PG8_BAR; PG8_SCHED;
            PG8_LDB(B1, 1, 1); PG8_STAGE(PG8_SB(1, 0), b3, voffB);
            PG8_BAR; PG8_WAIT_L(0); PG8_MMA(0, 1, At, B1); PG8_BAR;
            PG8_LDA(At, 1, 1); PG8_STAGE(PG8_SA(1, 0), a3, voffA);
            PG8_BAR; PG8_WAIT_L(0); PG8_MMA(1, 0, At, B0); PG8_BAR; PG8_SCHED;
            PG8_STAGE(PG8_SB(1, 1), b3 + hstep, voffB);
            PG8_WAIT_V(6); PG8_BAR; PG8_MMA(1, 1, At, B1); PG8_BAR;
            }
        }
        if constexpr (ALIGN_EPI) { if (wr == 0) PG8_BAR; }
        if constexpr (!Epi::AFTER_DRAIN) { E(acc, cur, wr, wc, fr, fq); S.done(cur); }
        if (!has_next) break;
#pragma unroll
        for (int a = 0; a < 2; ++a)
#pragma unroll
            for (int b = 0; b < 2; ++b)
#pragma unroll
                for (int m = 0; m < 4; ++m)
#pragma unroll
                    for (int n = 0; n < 2; ++n) acc[a][b][m][n] = (f32x4){0.f, 0.f, 0.f, 0.f};
        cur = nxt; cA = nA; cB = nB; ++ui;
        if constexpr (ALIGN_EPI) { if (wr == 1) PG8_BAR; }
    }
    PG8_WAIT_V(0);
    if constexpr (!ALIGN_EPI) { if (wr == 0) PG8_BAR; }
    PG8_BAR;
    if constexpr (Epi::AFTER_DRAIN) { E.fused(acc, cur, wr, wc, fr, fq, lds, wid, lane); S.done(cur); }
#undef PG8_SA
#undef PG8_SB
#undef PG8_STAGE
#undef PG8_LDA
#undef PG8_LDB
#undef PG8_MMA
#undef PG8_WAIT_V
#undef PG8_WAIT_L
#undef PG8_BAR
#undef PG8_SCHED
}
}
namespace pg8 {
typedef unsigned u32x2 __attribute__((ext_vector_type(2)));
constexpr int MTOK = 16384, DM = 1024, DFF = 2816, SEQL = 2048;
__device__ __forceinline__ float sigmoid_f(float x) { return __builtin_amdgcn_rcpf(1.f + __expf(-x)); }
__device__ __forceinline__ float gelu_tanh_f(float x) { return x * sigmoid_f(1.5957691216057308f * (x + 0.044715f * x * x * x)); }
__device__ __forceinline__ f32x4 gelu4(f32x4 x) { const f32x4 t = x * ((x * x) * -0.10294324f + -2.3022082f); f32x4 ex;
    ex[0] = __builtin_amdgcn_exp2f(t[0]); ex[1] = __builtin_amdgcn_exp2f(t[1]); ex[2] = __builtin_amdgcn_exp2f(t[2]); ex[3] = __builtin_amdgcn_exp2f(t[3]);
    const f32x4 d = ex + 1.0f; f32x4 q; q[0] = __builtin_amdgcn_rcpf(d[0]); q[1] = __builtin_amdgcn_rcpf(d[1]); q[2] = __builtin_amdgcn_rcpf(d[2]); q[3] = __builtin_amdgcn_rcpf(d[3]);
    return x * q; }
__device__ __forceinline__ float bf2f(unsigned short v) { return __uint_as_float((unsigned)v << 16); }
typedef const PG8_LAS float* rtab_t;
template <class Sched> __device__ __forceinline__ void fill_rinv(const Sched& S, const float* ssq, PG8_LAS float* rt, int tid) {
    asm volatile("" : "+v"(tid));
    PG8_LAS int* pml = (PG8_LAS int*)(rt + 8 * 256);
    if (tid < 8) { Unit u; u.pm = -1; pml[tid] = S.next(tid, u) ? u.pm : -1; }
    __syncthreads();
    f32x4 p[4][4]; int pmv[4];
#pragma unroll
    for (int k = 0; k < 4; ++k) { const int idx = tid + 512 * k; pmv[k] = pml[idx >> 8];
        if (pmv[k] >= 0) { const f32x4* q = (const f32x4*)(ssq + (size_t)(pmv[k] * BM + (idx & 255)) * 16); p[k][0] = q[0]; p[k][1] = q[1]; p[k][2] = q[2]; p[k][3] = q[3]; } }
#pragma unroll
    for (int k = 0; k < 4; ++k) if (pmv[k] >= 0) { const f32x4 a = (p[k][0] + p[k][1]) + (p[k][2] + p[k][3]); rt[tid + 512 * k] = __builtin_amdgcn_rsqf(((a[0] + a[1]) + (a[2] + a[3])) * (1.0f / DM) + 1e-6f); }
    __syncthreads();
}
struct IdxOrder { StaticOrder S; const float* ssq; PG8_LAS float* rt;
    __device__ __forceinline__ bool next(int i, Unit& u) const { u.idx = i; return S.next(i, u); }
    __device__ __forceinline__ void a_ready(const Unit&) const {}
    __device__ __forceinline__ void done(const Unit&) const {}
    __device__ __forceinline__ void pre(int tid) const { fill_rinv(*this, ssq, rt, tid); }
};
__device__ __forceinline__ size_t blk_off(int row, int ch) { const int b = row >> 11, t = row & (SEQL - 1); return ((((size_t)(b * 64 + (ch >> 4)) * 8 + (t & 7)) * 256 + (t >> 3)) * 16 + (ch & 15)); }
#define PG8_FENCE do { asm volatile("" ::: "memory"); __builtin_amdgcn_sched_barrier(0); } while (0)
struct EpiInProj {
    static constexpr bool PERM = true, AFTER_DRAIN = false;
    rtab_t rt; bf16_t* G; bf16_t* REC;
    __device__ __forceinline__ void operator()(const f32x4 (&acc)[2][2][4][2], const Unit& u, int wr, int wc, int fr, int fq) const {
        asm volatile("" : "+v"(fr), "+v"(fq));
        const int row0 = u.pm * BM + wr * 64 + fr; rtab_t rr = rt + u.idx * 256 + wr * 64 + fr;
        const bool isg = u.pn < 4; const int col0 = (u.pn & 3) * BM + wc * 32 + 8 * fq;
#pragma unroll
        for (int ai = 0; ai < 2; ++ai)
#pragma unroll
            for (int m = 0; m < 4; ++m) { const int row = row0 + ai * HALF + m * 16; const float r = rr[ai * HALF + m * 16];
#pragma unroll
                for (int bj = 0; bj < 2; ++bj) { f32x4 v0 = acc[ai][bj][m][0] * r, v1 = acc[ai][bj][m][1] * r;
                    if (isg) { v0 = gelu4(v0); v1 = gelu4(v1); }
                    u32x4 w; w.x = cvt_pk_bf16(v0[0], v0[1]); w.y = cvt_pk_bf16(v0[2], v0[3]); w.z = cvt_pk_bf16(v1[0], v1[1]); w.w = cvt_pk_bf16(v1[2], v1[3]);
                    bf16_t* dst = isg ? G + blk_off(row, col0 + bj * HALF) : REC + (size_t)row * DM + col0 + bj * HALF;
                    *(u32x4*)dst = w; } if (m & 1) PG8_FENCE; }
    }
};
struct EpiGates {
    static constexpr bool PERM = true, AFTER_DRAIN = false;
    const bf16_t* RECC; const float* bg; const float* sp8t; bf16_t* LA; bf16_t* UP;
    __device__ __forceinline__ void operator()(const f32x4 (&acc)[2][2][4][2], const Unit& u, int wr, int wc, int fr, int fq) const {
        asm volatile("" : "+v"(fr), "+v"(fq));
        const int n = u.pm >> 6, pm = u.pm & 63, pnl = u.pn & 1; const int row0 = pm * BM + wr * 64 + fr;
        u32x2 xall[2][2][4];
#pragma unroll
        for (int nn = 0; nn < 2; ++nn)
#pragma unroll
            for (int ai = 0; ai < 2; ++ai)
#pragma unroll
                for (int m = 0; m < 4; ++m) xall[nn][ai][m] = *(const u32x2*)(RECC + ((size_t)n * MTOK + row0 + ai * HALF + m * 16) * 256 + pnl * HALF + wc * 32 + 8 * fq + 4 * nn);
#pragma unroll
        for (int nn = 0; nn < 2; ++nn) { const int cl0 = pnl * HALF + wc * 32 + 8 * fq + 4 * nn;
            const f32x4 bi = *(const f32x4*)(bg + n * 512 + cl0), br = *(const f32x4*)(bg + n * 512 + 256 + cl0), sp = *(const f32x4*)(sp8t + n * 256 + cl0);
#pragma unroll
            for (int ai = 0; ai < 2; ++ai)
#pragma unroll
                for (int m = 0; m < 4; ++m) { const int row = row0 + ai * HALF + m * 16;
                    const u32x2 xr = xall[nn][ai][m];
                    f32x4 ti = (acc[ai][0][m][nn] + bi) * -1.4426950408889634f, tr = (acc[ai][1][m][nn] + br) * -1.4426950408889634f, ei, er;
#pragma unroll
                    for (int j = 0; j < 4; ++j) { ei[j] = __builtin_amdgcn_exp2f(fminf(ti[j], 57.f)); er[j] = __builtin_amdgcn_exp2f(fminf(tr[j], 57.f)); }
                    ei = ei + 1.0f; er = er + 1.0f; const f32x4 pr = ei * er; f32x4 rc;
                    rc[0] = __builtin_amdgcn_rcpf(pr[0]); rc[1] = __builtin_amdgcn_rcpf(pr[1]); rc[2] = __builtin_amdgcn_rcpf(pr[2]); rc[3] = __builtin_amdgcn_rcpf(pr[3]);
                    const f32x4 xv = {__uint_as_float(xr[0] << 16), __uint_as_float(xr[0] & 0xffff0000u), __uint_as_float(xr[1] << 16), __uint_as_float(xr[1] & 0xffff0000u)};
                    const f32x4 lav = sp * (ei * rc), uv = xv * (er * rc);
                    const size_t off = blk_off(row, n * 256 + cl0);
                    u32x2 w0; w0.x = cvt_pk_bf16(lav[0], lav[1]); w0.y = cvt_pk_bf16(lav[2], lav[3]); *(u32x2*)(LA + off) = w0;
                    u32x2 w; w.x = cvt_pk_bf16(uv[0], uv[1]); w.y = cvt_pk_bf16(uv[2], uv[3]); *(u32x2*)(UP + off) = w; if (m & 1) PG8_FENCE; } }
    }
};
struct EpiRes {
    static constexpr bool PERM = true, AFTER_DRAIN = false;
    bf16_t* HB; float* SSQ;
    __device__ __forceinline__ void operator()(const f32x4 (&acc)[2][2][4][2], const Unit& u, int wr, int wc, int fr, int fq) const {
        asm volatile("" : "+v"(fr), "+v"(fq));
        const int row0 = u.pm * BM + wr * 64 + fr, col0 = u.pn * BM + wc * 32 + 8 * fq;
#pragma unroll
        for (int ai = 0; ai < 2; ++ai) {
            u32x4 old[4][2];
#pragma unroll
            for (int m = 0; m < 4; ++m)
#pragma unroll
                for (int bj = 0; bj < 2; ++bj) old[m][bj] = *(const u32x4*)(HB + (size_t)(row0 + ai * HALF + m * 16) * DM + col0 + bj * HALF);
#pragma unroll
            for (int m = 0; m < 4; ++m) { const int row = row0 + ai * HALF + m * 16; float s = 0.f;
#pragma unroll
                for (int bj = 0; bj < 2; ++bj) { bf16_t* p = HB + (size_t)row * DM + col0 + bj * HALF; float h[8];
#pragma unroll
                    for (int j = 0; j < 8; ++j) { const unsigned w = old[m][bj][j >> 1]; h[j] = ((j & 1) ? __uint_as_float(w & 0xffff0000u) : __uint_as_float(w << 16)) + acc[ai][bj][m][j >> 2][j & 3]; s += h[j] * h[j]; }
                    u32x4 o; o.x = cvt_pk_bf16(h[0], h[1]); o.y = cvt_pk_bf16(h[2], h[3]); o.z = cvt_pk_bf16(h[4], h[5]); o.w = cvt_pk_bf16(h[6], h[7]);
                    *(u32x4*)p = o; }
                s += __shfl_xor(s, 16); s += __shfl_xor(s, 32);
                if (fq == 0) SSQ[(size_t)row * 16 + u.pn * 4 + wc] = s; }
            PG8_FENCE; }
    }
};
struct EpiFfnIn {
    static constexpr bool PERM = true, AFTER_DRAIN = false;
    rtab_t rt; bf16_t* ACT;
    __device__ __forceinline__ void operator()(const f32x4 (&acc)[2][2][4][2], const Unit& u, int wr, int wc, int fr, int fq) const {
        asm volatile("" : "+v"(fr), "+v"(fq));
        const int row0 = u.pm * BM + wr * 64 + fr; rtab_t rr = rt + u.idx * 256 + wr * 64 + fr;
        const int col0 = u.pn * HALF + wc * 32 + 8 * fq;
#pragma unroll
        for (int ai = 0; ai < 2; ++ai)
#pragma unroll
            for (int m = 0; m < 4; ++m) { const float r = rr[ai * HALF + m * 16]; const float r2 = r * -1.4426950408889634f, rq = r * r;
                f32x4 v[2];
#pragma unroll
                for (int nn = 0; nn < 2; ++nn) { const f32x4 g = acc[ai][0][m][nn], up = acc[ai][1][m][nn]; const f32x4 t = g * r2; f32x4 ex;
                    ex[0] = __builtin_amdgcn_exp2f(t[0]); ex[1] = __builtin_amdgcn_exp2f(t[1]); ex[2] = __builtin_amdgcn_exp2f(t[2]); ex[3] = __builtin_amdgcn_exp2f(t[3]);
                    const f32x4 d = ex + 1.0f; f32x4 q; q[0] = __builtin_amdgcn_rcpf(d[0]); q[1] = __builtin_amdgcn_rcpf(d[1]); q[2] = __builtin_amdgcn_rcpf(d[2]); q[3] = __builtin_amdgcn_rcpf(d[3]);
                    v[nn] = (g * up) * (q * rq); }
                u32x4 w; w.x = cvt_pk_bf16(v[0][0], v[0][1]); w.y = cvt_pk_bf16(v[0][2], v[0][3]); w.z = cvt_pk_bf16(v[1][0], v[1][1]); w.w = cvt_pk_bf16(v[1][2], v[1][3]);
                *(u32x4*)(ACT + (size_t)(row0 + ai * HALF + m * 16) * DFF + col0) = w; if (m & 1) PG8_FENCE; }
    }
};
struct EpiQkvf {
    static constexpr bool PERM = true, AFTER_DRAIN = false;
    rtab_t rt; bf16_t* Q; bf16_t* K; bf16_t* VT; float* FL; const float* bf;
    __device__ __forceinline__ void operator()(const f32x4 (&acc)[2][2][4][2], const Unit& u, int wr, int wc, int fr, int fq) const {
        asm volatile("" : "+v"(fr), "+v"(fq));
        const int row0 = u.pm * BM + wr * 64 + fr; rtab_t rr = rt + u.idx * 256 + wr * 64 + fr;
        const int grp = u.pn >> 2, col0 = (u.pn & 3) * BM + wc * 32 + 8 * fq;
        if (grp < 2) { bf16_t* base = grp == 0 ? Q : K; const float sc = grp == 0 ? 0.125f * 1.4426950408889634f : 1.0f;
#pragma unroll
            for (int ai = 0; ai < 2; ++ai)
#pragma unroll
                for (int m = 0; m < 4; ++m) { bf16_t* rowp = base + (size_t)(row0 + ai * HALF + m * 16) * DM + col0; const float r = rr[ai * HALF + m * 16] * sc;
#pragma unroll
                    for (int bj = 0; bj < 2; ++bj) { const f32x4 v0 = acc[ai][bj][m][0] * r, v1 = acc[ai][bj][m][1] * r;
                        u32x4 w; w.x = cvt_pk_bf16(v0[0], v0[1]); w.y = cvt_pk_bf16(v0[2], v0[3]); w.z = cvt_pk_bf16(v1[0], v1[1]); w.w = cvt_pk_bf16(v1[2], v1[3]);
                        *(u32x4*)(rowp + bj * HALF) = w; } }
        } else if (grp == 2) {
#pragma unroll
            for (int ai = 0; ai < 2; ++ai)
#pragma unroll
                for (int m = 0; m < 4; ++m) { const int row = row0 + ai * HALF + m * 16; const int b = row >> 11, t = row & (SEQL - 1); const float r = rr[ai * HALF + m * 16];
#pragma unroll
                    for (int bj = 0; bj < 2; ++bj)
#pragma unroll
                        for (int j = 0; j < 8; ++j) { const int col = col0 + bj * HALF + j;
                            const unsigned w = cvt_pk_bf16(acc[ai][bj][m][j >> 2][j & 3] * r, 0.f);
                            VT[((size_t)b * DM + col) * SEQL + t] = (bf16_t)(w & 0xffffu); } }
        }
    }
};
struct GatesOrder {
    int G, c;
    __device__ __forceinline__ bool next(int i, Unit& u) const { const int L = i * G + c; if (L >= 512) return false; const int n = L >> 7, rem = L & 127; u.pm = n * 64 + (rem >> 1); u.pn = n * 2 + (rem & 1); return true; }
    __device__ __forceinline__ void a_ready(const Unit&) const {}
    __device__ __forceinline__ void done(const Unit&) const {}
    __device__ __forceinline__ void pre(int) const {}
};
}
#define LAS __attribute__((address_space(3)))
typedef unsigned short bf16;
typedef float f32x4 __attribute__((ext_vector_type(4)));
typedef float f32x16 __attribute__((ext_vector_type(16)));
typedef unsigned u32x4 __attribute__((ext_vector_type(4)));
typedef unsigned u32x2 __attribute__((ext_vector_type(2)));
typedef short bf16x8 __attribute__((ext_vector_type(8)));
constexpr int M = 16384, D = 1024, SEQ = 2048, NB = 8, NH = 16, FF = 2816, NQKVF = 3328;
constexpr int NTHREADS = 512, NWAVES = 8, LDS_BYTES = 147456;
constexpr size_t MiB = 1u << 20;
constexpr size_t WS_WRECIN = 1 * MiB, WS_WGATES = 9 * MiB, WS_WRECOUT = 11 * MiB, WS_WFFNIN = 15 * MiB, WS_WFFNOUT = 59 * MiB, WS_WQKVF = 81 * MiB, WS_WQ1 = 88 * MiB, WS_WO = 90 * MiB;
constexpr size_t WS_HB = 94 * MiB, WS_SSQ = 126 * MiB, WS_FL = 127 * MiB, WS_C2 = 128 * MiB, WS_X0 = 129 * MiB, WS_X1 = 161 * MiB, WS_X2 = 193 * MiB, WS_Z = 225 * MiB, WS_ZU = 289 * MiB, WS_END = 321 * MiB;
constexpr size_t WS_BAR = 65536;
constexpr int NCD = 25;
struct ConvDesc { const float* W; const float* gain; bf16* WT; int ldw, K, groups, half, nvalid, start; };
struct Args { const float* in[18]; float* out; unsigned char* ws; ConvDesc cd[NCD]; int total_items; int pad; };

__device__ __forceinline__ unsigned pk_bf16(float lo, float hi) { return pg8::cvt_pk_bf16(lo, hi); }
__device__ __forceinline__ float wave_sum(float v) {
#pragma unroll
    for (int o = 1; o < 64; o <<= 1) v += __shfl_xor(v, o);
    return v;
}
#define XB_TMO      128
#define XB_XCNT(j)  (256  + 64 * (j))
#define XB_XSUB(j)  (1280 + 64 * (j))
#define XB_XGEN(j)  (2304 + 64 * (j))
#define XB_TOP      3328
#define XB_TOPGEN   3392
#define XCD_BAR_WORDS 3456
#define XB_SPIN_CAP (1u << 18)

__device__ __forceinline__ unsigned xb_ld(unsigned* p)              { return __hip_atomic_load(p, __ATOMIC_RELAXED, __HIP_MEMORY_SCOPE_AGENT); }
__device__ __forceinline__ unsigned xb_add(unsigned* p, unsigned v) { return __hip_atomic_fetch_add(p, v, __ATOMIC_RELAXED, __HIP_MEMORY_SCOPE_AGENT); }
__device__ __forceinline__ unsigned xb_xcc_id() { return (unsigned)__builtin_amdgcn_s_getreg((3 << 11) | 20) & 0xFu; }
#define XB_SPIN(cond, bar) do { unsigned _sp = 0; while (cond) { __builtin_amdgcn_s_sleep(1); \
    if ((++_sp & 255u) == 0u) { if (xb_ld(&(bar)[XB_TMO])) break; if (_sp > XB_SPIN_CAP) { atomicAdd(&(bar)[XB_TMO], 1u); break; } } } } while (0)

struct XcdBarrier {
    unsigned* bar; unsigned x;
    volatile LAS unsigned* st;
};

__device__ __forceinline__ XcdBarrier xcd_barrier_post(unsigned* bar, volatile LAS unsigned* st) {
    XcdBarrier b; b.bar = bar; b.x = xb_xcc_id(); b.st = st;
    if (threadIdx.x == 0) (void)xb_add(&bar[XB_XCNT(b.x)], 1u);
    return b;
}
__device__ __forceinline__ void xcd_barrier_complete(unsigned* bar, unsigned x, unsigned& nloc, unsigned& nx) {
    const unsigned G = gridDim.x * gridDim.y * gridDim.z;
    unsigned sum, cnt, mine, sp = 0u;
    for (;;) {
        sum = 0u; cnt = 0u; mine = 0u;
#pragma unroll
        for (unsigned j = 0; j < 16; ++j) { const unsigned c = xb_ld(&bar[XB_XCNT(j)]); sum += c; cnt += (c > 0u) ? 1u : 0u; mine = (j == x) ? c : mine; }
        if (sum == G) break;
        __builtin_amdgcn_s_sleep(1);
        if ((++sp & 255u) == 0u) { if (xb_ld(&bar[XB_TMO])) break; if (sp > XB_SPIN_CAP) { atomicAdd(&bar[XB_TMO], 1u); break; } }
    }
    nloc = mine > 0u ? mine : 1u; nx = cnt > 0u ? cnt : 1u;
}

__device__ __forceinline__ void xcd_barrier(const XcdBarrier& b) {
    asm volatile("s_waitcnt vmcnt(0)" ::: "memory");
    __syncthreads();
    if (threadIdx.x == 0) {
        unsigned* bar = b.bar;
        __builtin_amdgcn_s_waitcnt(0);
        unsigned nloc = b.st[0], nx = b.st[1];
        if (nloc == 0u) { xcd_barrier_complete(bar, b.x, nloc, nx); b.st[0] = nloc; b.st[1] = nx; }
        const unsigned old = xb_add(&bar[XB_XSUB(b.x)], 1u);
        const unsigned gen = old / nloc;
        if (old + 1u == (gen + 1u) * nloc) {
            __builtin_amdgcn_fence(__ATOMIC_RELEASE, "agent");
            asm volatile("s_waitcnt vmcnt(0)" ::: "memory");
            const unsigned og = xb_add(&bar[XB_TOP], 1u);
            const unsigned tg = og / nx;
            if (og + 1u == (tg + 1u) * nx) xb_add(&bar[XB_TOPGEN], 1u);
            else XB_SPIN(xb_ld(&bar[XB_TOPGEN]) == tg, bar);
            __builtin_amdgcn_fence(__ATOMIC_ACQUIRE, "agent");
            xb_add(&bar[XB_XGEN(b.x)], 1u);
            asm volatile("s_waitcnt vmcnt(0)" ::: "memory");
        } else {
            XB_SPIN(xb_ld(&bar[XB_XGEN(b.x)]) == gen, bar);
            __builtin_amdgcn_fence(__ATOMIC_ACQUIRE, "agent");
            asm volatile("s_waitcnt vmcnt(0)" ::: "memory");
        }
    }
    __syncthreads();
}
__device__ __forceinline__ void convert_item(const ConvDesc& d, int item, LAS float* scr, int lane) {
    const int kb = item / d.groups, g = item - kb * d.groups, k0 = 64 * kb, n0 = 32 * g;
    int sc0 = n0; if (d.half) { const int pn = n0 >> 8, bj = (n0 >> 7) & 1, jj = n0 & 127; sc0 = bj * d.half + 128 * pn + jj; }
    const int c = lane & 31; const bool valid = (sc0 + c) < d.nvalid;
    float v[32];
#pragma unroll
    for (int i = 0; i < 32; ++i) { const int kk = 2 * i + (lane >> 5); v[i] = valid ? d.W[(size_t)(k0 + kk) * d.ldw + sc0 + c] : 0.f; }
    if (d.gain) {
#pragma unroll
        for (int i = 0; i < 32; ++i) v[i] *= d.gain[k0 + 2 * i + (lane >> 5)]; }
#pragma unroll
    for (int i = 0; i < 32; ++i) scr[(2 * i + (lane >> 5)) * 33 + c] = v[i];
    asm volatile("s_waitcnt lgkmcnt(0)" ::: "memory");
    const int ch = lane & 7;
#pragma unroll
    for (int j = 0; j < 4; ++j) { const int n = (lane >> 3) + 8 * j; const LAS float* s = scr + (8 * ch) * 33 + n;
        u32x4 o; o.x = pk_bf16(s[0 * 33], s[1 * 33]); o.y = pk_bf16(s[2 * 33], s[3 * 33]); o.z = pk_bf16(s[4 * 33], s[5 * 33]); o.w = pk_bf16(s[6 * 33], s[7 * 33]);
        *(u32x4*)(d.WT + (size_t)(n0 + n) * d.K + k0 + 8 * ch) = o; }
    asm volatile("s_waitcnt lgkmcnt(0)" ::: "memory");
}
__device__ __forceinline__ void conv_phase(const bf16* REC, const float* cw, const float* cb, bf16* RECC, int tid) {
    for (int it = blockIdx.x * NTHREADS + tid; it < 128 * 1024; it += gridDim.x * NTHREADS) {
        const int c = it & 127, run = it >> 7, tok0 = run * 16; const bool first = (tok0 & (SEQ - 1)) == 0;
        float w[4][8], bb[8], x0[8], x1[8], x2[8];
#pragma unroll
        for (int tp = 0; tp < 4; ++tp) { const f32x4 a = *(const f32x4*)(cw + tp * D + c * 8), b = *(const f32x4*)(cw + tp * D + c * 8 + 4);
            w[tp][0] = a[0]; w[tp][1] = a[1]; w[tp][2] = a[2]; w[tp][3] = a[3]; w[tp][4] = b[0]; w[tp][5] = b[1]; w[tp][6] = b[2]; w[tp][7] = b[3]; }
        { const f32x4 a = *(const f32x4*)(cb + c * 8), b = *(const f32x4*)(cb + c * 8 + 4); bb[0] = a[0]; bb[1] = a[1]; bb[2] = a[2]; bb[3] = a[3]; bb[4] = b[0]; bb[5] = b[1]; bb[6] = b[2]; bb[7] = b[3]; }
        const bf16* src = REC + (size_t)tok0 * D + c * 8;
        u32x4 r0 = {0u, 0u, 0u, 0u}, r1 = r0, r2 = r0;
        if (!first) { r0 = *(const u32x4*)(src - 3 * D); r1 = *(const u32x4*)(src - 2 * D); r2 = *(const u32x4*)(src - D); }
#pragma unroll
        for (int j = 0; j < 4; ++j) { x0[2 * j] = __uint_as_float(r0[j] << 16); x0[2 * j + 1] = __uint_as_float(r0[j] & 0xffff0000u);
            x1[2 * j] = __uint_as_float(r1[j] << 16); x1[2 * j + 1] = __uint_as_float(r1[j] & 0xffff0000u);
            x2[2 * j] = __uint_as_float(r2[j] << 16); x2[2 * j + 1] = __uint_as_float(r2[j] & 0xffff0000u); }
        bf16* dst = RECC + ((size_t)(c >> 5) * M + tok0) * 256 + (c & 31) * 8;
#pragma unroll
        for (int i = 0; i < 16; ++i) { const u32x4 rc = *(const u32x4*)(src + (size_t)i * D); float xc[8], y[8];
#pragma unroll
            for (int j = 0; j < 4; ++j) { xc[2 * j] = __uint_as_float(rc[j] << 16); xc[2 * j + 1] = __uint_as_float(rc[j] & 0xffff0000u); }
#pragma unroll
            for (int j = 0; j < 8; ++j) { y[j] = bb[j] + w[0][j] * x0[j] + w[1][j] * x1[j] + w[2][j] * x2[j] + w[3][j] * xc[j]; x0[j] = x1[j]; x1[j] = x2[j]; x2[j] = xc[j]; }
            u32x4 o; o.x = pk_bf16(y[0], y[1]); o.y = pk_bf16(y[2], y[3]); o.z = pk_bf16(y[4], y[5]); o.w = pk_bf16(y[6], y[7]);
            *(u32x4*)(dst + (size_t)i * 256) = o; }
    }
}
__device__ __forceinline__ void scan_phase(const bf16* LA, const bf16* UP, const bf16* G, bf16* Y, LAS unsigned char* lds, int tid) {
    LAS float* sW = (LAS float*)lds;
    const int lane = tid & 63, wid = tid >> 6, hf = tid & 1, c = tid >> 1, cw = lane >> 1;
    for (int item = 2 * blockIdx.x; item < 512; item += 2 * gridDim.x)
#pragma unroll 1
    for (int sub = 0; sub < 2; ++sub) {
        const int it = item + sub, b = it >> 6, cg = it & 63;
        const size_t base = ((size_t)b * SEQ + c * 8) * D + cg * 16 + hf * 8;
        const size_t bb = ((size_t)(b * 64 + cg) * 8 * 256 + c) * 16 + hf * 8;
        u32x4 ll[8], uu[8], gg[8];
#pragma unroll
        for (int i = 0; i < 8; ++i) { ll[i] = *(const u32x4*)(LA + bb + (size_t)i * 4096); uu[i] = *(const u32x4*)(UP + bb + (size_t)i * 4096); gg[i] = *(const u32x4*)(G + bb + (size_t)i * 4096); }
        float av[8][8];
        float P[8], H[8];
#pragma unroll
        for (int j = 0; j < 8; ++j) { P[j] = 1.f; H[j] = 0.f; }
#pragma unroll
        for (int i = 0; i < 8; ++i)
#pragma unroll
            for (int j = 0; j < 8; ++j) { const unsigned lw = ll[i][j >> 1]; const float la = (j & 1) ? __uint_as_float(lw & 0xffff0000u) : __uint_as_float(lw << 16);
                const float a = __expf(la); av[i][j] = a; const float mult = __builtin_sqrtf(fmaxf(1.0f - a * a, 0.f));
                const unsigned w = uu[i][j >> 1]; const float u = ((j & 1) ? __uint_as_float(w & 0xffff0000u) : __uint_as_float(w << 16)) * mult;
                H[j] = a * H[j] + u; P[j] *= a; }
#pragma unroll
        for (int off = 1; off < 32; off <<= 1) {
#pragma unroll
            for (int j = 0; j < 8; ++j) { const float pp = __shfl_up(P[j], 2 * off), hp = __shfl_up(H[j], 2 * off); if (cw >= off) { H[j] = P[j] * hp + H[j]; P[j] *= pp; } } }
        if (cw == 31) {
#pragma unroll
            for (int j = 0; j < 8; ++j) { sW[((wid * 2 + hf) * 8 + j) * 2] = P[j]; sW[((wid * 2 + hf) * 8 + j) * 2 + 1] = H[j]; } }
        __syncthreads();
        float h[8];
#pragma unroll
        for (int j = 0; j < 8; ++j) { float h0 = 0.f;
            for (int w = 0; w < wid; ++w) h0 = sW[((w * 2 + hf) * 8 + j) * 2] * h0 + sW[((w * 2 + hf) * 8 + j) * 2 + 1];
            float pe = __shfl_up(P[j], 2), he = __shfl_up(H[j], 2); if (cw == 0) { pe = 1.f; he = 0.f; }
            h[j] = pe * h0 + he; }
#pragma unroll
        for (int i = 0; i < 8; ++i) { float y[8];
#pragma unroll
            for (int j = 0; j < 8; ++j) { const float a = av[i][j]; const float mult = __builtin_sqrtf(fmaxf(1.0f - a * a, 0.f));
                const unsigned w = uu[i][j >> 1]; const float u = ((j & 1) ? __uint_as_float(w & 0xffff0000u) : __uint_as_float(w << 16)) * mult;
                const unsigned gw_ = gg[i][j >> 1]; const float g = (j & 1) ? __uint_as_float(gw_ & 0xffff0000u) : __uint_as_float(gw_ << 16);
                h[j] = a * h[j] + u; y[j] = h[j] * g; }
            u32x4 o; o.x = pk_bf16(y[0], y[1]); o.y = pk_bf16(y[2], y[3]); o.z = pk_bf16(y[4], y[5]); o.w = pk_bf16(y[6], y[7]);
            *(u32x4*)(Y + base + (size_t)i * D) = o; }
        __syncthreads();
    }
}
__device__ __forceinline__ float log_sigmoid_f(float x) { return fminf(x, 0.f) - log1pf(expf(-fabsf(x))); }
__device__ __forceinline__ void kmax_pass(const bf16* K, unsigned* KM2, int wid, int lane) {
    for (int task = blockIdx.x * NWAVES + wid; task < NB * NH * 16; task += gridDim.x * NWAVES) {
        const int bh = task >> 4, chunk = task & 15, b = bh >> 4, h = bh & 15; float best = 0.f;
#pragma unroll
        for (int kk = 0; kk < 2; ++kk) { const bf16* kp = K + ((size_t)b * SEQ + chunk * 128 + lane * 2 + kk) * D + h * 64; float s = 0.f;
#pragma unroll
            for (int j = 0; j < 8; ++j) { const u32x4 w = *(const u32x4*)(kp + j * 8);
#pragma unroll
                for (int e = 0; e < 4; ++e) { const float lo = __uint_as_float(w[e] << 16), hi_ = __uint_as_float(w[e] & 0xffff0000u); s += lo * lo + hi_ * hi_; } }
            best = fmaxf(best, s); }
#pragma unroll
        for (int o = 1; o < 64; o <<= 1) best = fmaxf(best, __shfl_xor(best, o));
        if (lane == 0) atomicMax(KM2 + bh, __float_as_uint(best));
    }
}
__device__ __forceinline__ void cphase(const float* FL, float* C2, int wid, int lane) {
    for (int gw = blockIdx.x * NWAVES + wid; gw < NB * NH; gw += gridDim.x * NWAVES) {
        const int b = gw >> 4, h = gw & 15; const float* src = FL + ((size_t)b * SEQ + lane * 32) * 16 + h;
        float v[32];
#pragma unroll
        for (int i = 0; i < 32; ++i) v[i] = src[i * 16];
        float s = 0.f;
#pragma unroll
        for (int i = 0; i < 32; ++i) { s += log_sigmoid_f(v[i]); v[i] = s; }
        float inc = s;
#pragma unroll
        for (int o = 1; o < 64; o <<= 1) { const float t = __shfl_up(inc, o); if (lane >= o) inc += t; }
        const float carry = inc - s; f32x4* dst = (f32x4*)(C2 + (size_t)gw * SEQ + lane * 32);
#pragma unroll
        for (int i = 0; i < 8; ++i) dst[i] = (f32x4){(v[4 * i] + carry) * -1.4426950408889634f, (v[4 * i + 1] + carry) * -1.4426950408889634f, (v[4 * i + 2] + carry) * -1.4426950408889634f, (v[4 * i + 3] + carry) * -1.4426950408889634f};
    }
}
__device__ __forceinline__ void f_phase(const bf16* HB, const float* SSQ, const bf16* Wf, const float* bfg, float* FL, LAS unsigned char* lds, int tid) {
    const int lane = tid & 63, wid = tid >> 6, r32 = lane & 31, hi = lane >> 5, kq = wid & 3, tsel = wid >> 2;
    LAS float* red = (LAS float*)lds;
    for (int t2 = blockIdx.x; t2 < M / 64; t2 += gridDim.x) {
        const int tok0 = (2 * t2 + tsel) * 32;
        const bf16* ap = HB + (size_t)(tok0 + r32) * D + kq * 256 + hi * 8; const bf16* bp = Wf + (size_t)r32 * D + kq * 256 + hi * 8;
        f32x16 acc;
#pragma unroll
        for (int r = 0; r < 16; ++r) acc[r] = 0.f;
#pragma unroll
        for (int k0 = 0; k0 < 256; k0 += 16) { const bf16x8 av = *(const bf16x8*)(ap + k0), bv = *(const bf16x8*)(bp + k0); acc = __builtin_amdgcn_mfma_f32_32x32x16_bf16(av, bv, acc, 0, 0, 0); }
#pragma unroll
        for (int r = 0; r < 16; ++r) red[((tsel * 4 + kq) * 16 + r) * 64 + lane] = acc[r];
        __syncthreads();
        if (kq == 0 && r32 < 16) { const float bias = bfg[r32];
#pragma unroll
            for (int r = 0; r < 16; ++r) { const int tok = tok0 + (r & 3) + 8 * (r >> 2) + 4 * hi; const f32x4* p = (const f32x4*)(SSQ + (size_t)tok * 16);
                const f32x4 s4 = (p[0] + p[1]) + (p[2] + p[3]); const float rinv = __builtin_amdgcn_rsqf(((s4[0] + s4[1]) + (s4[2] + s4[3])) * (1.0f / D) + 1e-6f);
                const float v = (red[((tsel * 4 + 0) * 16 + r) * 64 + lane] + red[((tsel * 4 + 1) * 16 + r) * 64 + lane]) + (red[((tsel * 4 + 2) * 16 + r) * 64 + lane] + red[((tsel * 4 + 3) * 16 + r) * 64 + lane]);
                FL[(size_t)tok * 16 + r32] = v * rinv + bias; } }
        __syncthreads();
    }
}
namespace att {
constexpr int RS = 144, TB = 64 * RS;
constexpr int OFF_K = 0, OFF_V = 2 * TB, OFF_C = 4 * TB;
__device__ __forceinline__ void attn_unit(int b, int h, int qb, const bf16* Q, const bf16* K, const bf16* VT, const float* C2, const unsigned* KM2, bf16* O, LAS unsigned char* lds, int tid) {
    const int lane = tid & 63, wid = __builtin_amdgcn_readfirstlane(tid >> 6), r32 = lane & 31, hi = lane >> 5;
    const int q0 = qb * 256, qw0 = q0 + wid * 32, q = qw0 + r32; const size_t rowbase = (size_t)b * SEQ;
    bf16x8 qf[4]; { const bf16* qp = Q + (rowbase + q) * D + h * 64 + hi * 8;
#pragma unroll
        for (int d0 = 0; d0 < 4; ++d0) qf[d0] = *(const bf16x8*)(qp + d0 * 16); }
    const float* cb = C2 + (size_t)(b * NH + h) * SEQ;
    float qn2 = 0.f;
#pragma unroll
    for (int d0 = 0; d0 < 4; ++d0)
#pragma unroll
        for (int e = 0; e < 8; ++e) { const float v = __uint_as_float((unsigned)(unsigned short)qf[d0][e] << 16); qn2 += v * v; }
    qn2 += __shfl_xor(qn2, 32);
    const float ubase = sqrtf(qn2 * __uint_as_float(KM2[b * NH + h])) * 1.0001f;
    LAS unsigned* votes = (LAS unsigned*)(lds + 131072 + 8192 + 192);
    const int NT = (q0 + 256) / 64;
    const int srow = tid >> 3, sch = tid & 7;
    const bf16* kg = K + (rowbase + srow) * D + h * 64 + sch * 8;
    const bf16* vg = VT + ((size_t)(b * NH + h) * 64 + srow) * SEQ + sch * 8;
    const int soff = srow * RS + sch * 16;
    int ckey = 0; { const int r = tid & 15, hh = (tid >> 4) & 1, half = (tid >> 5) & 1; const int rho = (r & 3) + 8 * (r >> 2) + 4 * hh; ckey = 32 * half + ((rho & ~12) | ((rho & 4) << 1) | ((rho & 8) >> 1)); }
    const int krow = (r32 & ~12) | ((r32 & 4) << 1) | ((r32 & 8) >> 1);
    f32x16 o0, o1;
#pragma unroll
    for (int r = 0; r < 16; ++r) { o0[r] = 0.f; o1[r] = 0.f; }
    float mrun = -1e30f, lrun = 0.f;
    u32x4 kr = *(const u32x4*)(kg + (size_t)(NT - 1) * 64 * D), vr = *(const u32x4*)(vg + (NT - 1) * 64); float cr = (tid < 64) ? cb[(NT - 1) * 64 + ckey] : 0.f;
    *(LAS u32x4*)(lds + OFF_K + soff) = kr; *(LAS u32x4*)(lds + OFF_V + soff) = vr; if (tid < 64) *(LAS float*)(lds + OFF_C + tid * 4) = cr;
    kr = *(const u32x4*)(kg + (size_t)(NT - 2) * 64 * D); vr = *(const u32x4*)(vg + (NT - 2) * 64); if (tid < 64) cr = cb[(NT - 2) * 64 + ckey];
    __syncthreads();
    for (int it = 0; it < NT; ++it) {
        const int t = NT - 1 - it; const int cur = it & 1; const bool more = (t > 0);
        const bool active = (64 * t <= qw0 + 31);
        f32x16 s0, s1; bf16x8 v00, v01, v02, v03, v10, v11, v12, v13;
        if (active) {
            const LAS unsigned char* kb = lds + OFF_K + cur * TB; const LAS float* cs = (const LAS float*)(lds + OFF_C + cur * 256);
#pragma unroll
            for (int i = 0; i < 4; ++i) { const f32x4 c0 = *(const LAS f32x4*)(cs + hi * 16 + 4 * i), c1 = *(const LAS f32x4*)(cs + 32 + hi * 16 + 4 * i);
#pragma unroll
                for (int j = 0; j < 4; ++j) { s0[4 * i + j] = c0[j]; s1[4 * i + j] = c1[j]; } }
            const LAS unsigned char* ka = kb + krow * RS + hi * 16;
#pragma unroll
            for (int d0 = 0; d0 < 4; ++d0) { const bf16x8 k0 = *(const LAS bf16x8*)(ka + d0 * 32), k1 = *(const LAS bf16x8*)(ka + 32 * RS + d0 * 32);
                s0 = __builtin_amdgcn_mfma_f32_32x32x16_bf16(k0, qf[d0], s0, 0, 0, 0); s1 = __builtin_amdgcn_mfma_f32_32x32x16_bf16(k1, qf[d0], s1, 0, 0, 0); }
            { const LAS unsigned char* va = lds + OFF_V + cur * TB + r32 * RS + hi * 16;
              v00 = *(const LAS bf16x8*)(va); v01 = *(const LAS bf16x8*)(va + 32); v02 = *(const LAS bf16x8*)(va + 64); v03 = *(const LAS bf16x8*)(va + 96);
              v10 = *(const LAS bf16x8*)(va + 32 * RS); v11 = *(const LAS bf16x8*)(va + 32 * RS + 32); v12 = *(const LAS bf16x8*)(va + 32 * RS + 64); v13 = *(const LAS bf16x8*)(va + 32 * RS + 96); }
        }
        if (more) { const int nb = cur ^ 1; *(LAS u32x4*)(lds + OFF_K + nb * TB + soff) = kr; *(LAS u32x4*)(lds + OFF_V + nb * TB + soff) = vr; if (tid < 64) *(LAS float*)(lds + OFF_C + nb * 256 + tid * 4) = cr; }
        if (t > 1) { kr = *(const u32x4*)(kg + (size_t)(t - 2) * 64 * D); vr = *(const u32x4*)(vg + (t - 2) * 64); if (tid < 64) cr = cb[(t - 2) * 64 + ckey]; }
        if (active) {
            if (64 * t + 63 > qw0) {
#pragma unroll
                for (int r = 0; r < 16; ++r) { const int key = 64 * t + 16 * (r >> 3) + 8 * hi + (r & 7); if (key > q) s0[r] = -1e30f; if (key + 32 > q) s1[r] = -1e30f; } }
#define MX3(a_, b_, c_) __builtin_fmaxf(__builtin_fmaxf((a_), (b_)), (c_))
            float mxa = MX3(s0[0], s0[1], s1[0]), mxb = MX3(s0[2], s0[3], s1[1]); mxa = MX3(mxa, s1[2], s1[3]);
#pragma unroll
            for (int r = 4; r < 16; r += 4) { mxa = MX3(mxa, s0[r], s0[r + 1]); mxb = MX3(mxb, s0[r + 2], s0[r + 3]); mxa = MX3(mxa, s1[r], s1[r + 1]); mxb = MX3(mxb, s1[r + 2], s1[r + 3]); }
            float mx = __builtin_fmaxf(mxa, mxb);
#undef MX3
            mx = fmaxf(mx, __shfl_xor(mx, 32));
            if (__any(mx > mrun - 40.0f)) {
            const float mnew = fmaxf(mrun, mx); const float alpha = __builtin_amdgcn_exp2f(mrun - mnew); mrun = mnew;
            if (__any(alpha != 1.0f)) {
#pragma unroll
                for (int r = 0; r < 16; ++r) { o0[r] *= alpha; o1[r] *= alpha; } }
            float rs = 0.f;
#define PV_GROUP(SV, B0, VA, VB) { float e_[8]; \
                _Pragma("unroll") for (int j = 0; j < 8; ++j) { e_[j] = __builtin_amdgcn_exp2f(SV[(B0) + j] - mnew); rs += e_[j]; } \
                u32x4 pw_; pw_.x = pk_bf16(e_[0], e_[1]); pw_.y = pk_bf16(e_[2], e_[3]); pw_.z = pk_bf16(e_[4], e_[5]); pw_.w = pk_bf16(e_[6], e_[7]); \
                const bf16x8 pp_ = __builtin_bit_cast(bf16x8, pw_); \
                o0 = __builtin_amdgcn_mfma_f32_32x32x16_bf16(VA, pp_, o0, 0, 0, 0); o1 = __builtin_amdgcn_mfma_f32_32x32x16_bf16(VB, pp_, o1, 0, 0, 0); \
                __builtin_amdgcn_sched_barrier(0); }
            PV_GROUP(s0, 0, v00, v10) PV_GROUP(s0, 8, v01, v11) PV_GROUP(s1, 0, v02, v12) PV_GROUP(s1, 8, v03, v13)
#undef PV_GROUP
            lrun = lrun * alpha + rs;
            }
        }
        { bool ok = false;
          if (more && 64 * t <= qw0 + 31) ok = __all(ubase + cb[64 * t - 1] < mrun - 40.0f);
          if (lane == 0) votes[(it & 1) * 8 + wid] = ok ? 1u : 0u; }
        __syncthreads();
        if (more) { const LAS unsigned* vv = votes + (it & 1) * 8; if ((vv[0] & vv[1] & vv[2] & vv[3] & vv[4] & vv[5] & vv[6] & vv[7]) != 0u) break; }
    }
    const float lt = lrun + __shfl_xor(lrun, 32); const float il = 1.0f / lt;
    bf16* op = O + (rowbase + q) * D + h * 64 + 4 * hi;
#pragma unroll
    for (int g = 0; g < 4; ++g) { u32x2 w0, w1;
        w0.x = pk_bf16(o0[4 * g] * il, o0[4 * g + 1] * il); w0.y = pk_bf16(o0[4 * g + 2] * il, o0[4 * g + 3] * il);
        w1.x = pk_bf16(o1[4 * g] * il, o1[4 * g + 1] * il); w1.y = pk_bf16(o1[4 * g + 2] * il, o1[4 * g + 3] * il);
        *(u32x2*)(op + 8 * g) = w0; *(u32x2*)(op + 32 + 8 * g) = w1; }
}
__device__ __forceinline__ void attn_phase(const bf16* Q, const bf16* K, const bf16* VT, const float* C2, const unsigned* KM2, bf16* O, LAS unsigned char* lds, int tid, unsigned* ctr) {
    LAS unsigned* slot = (LAS unsigned*)(lds + 131072 + 8192 + 128);
    for (;;) {
        if (tid == 0) *slot = __hip_atomic_fetch_add(ctr, 1u, __ATOMIC_RELAXED, __HIP_MEMORY_SCOPE_AGENT);
        __syncthreads();
        const int pu = (int)*slot;
        __syncthreads();
        if (pu >= NB * NH * 8) break;
        const int h = 15 - (pu >> 6), qb = 7 - ((pu >> 3) & 7), b = pu & 7;
        attn_unit(b, h, qb, Q, K, VT, C2, KM2, O, lds, tid);
    }
}
}

#ifndef REP_PRO
#define REP_PRO 1
#endif
#ifndef REP_CONV
#define REP_CONV 1
#endif
#ifndef REP_SCAN
#define REP_SCAN 1
#endif
#ifndef REP_ATT
#define REP_ATT 1
#endif
#ifndef REP_FFNIN
#define REP_FFNIN 1
#endif
#ifndef REP_INPROJ
#define REP_INPROJ 1
#endif
#ifndef REP_GATES
#define REP_GATES 1
#endif
#ifndef REP_QKVF
#define REP_QKVF 1
#endif
__global__ void __launch_bounds__(NTHREADS, 2) fwd_megakernel(Args a) {
    extern __shared__ __attribute__((aligned(16))) unsigned char lds_raw[];
    LAS unsigned char* lds = (LAS unsigned char*)lds_raw;
    const int tid = threadIdx.x, lane = tid & 63, wid = __builtin_amdgcn_readfirstlane(tid >> 6);
    const int G = gridDim.x, bx = blockIdx.x;
    unsigned char* ws = a.ws;
    bf16* HB = (bf16*)(ws + WS_HB); float* SSQ = (float*)(ws + WS_SSQ); float* FL = (float*)(ws + WS_FL); float* C2 = (float*)(ws + WS_C2);
    bf16* X0 = (bf16*)(ws + WS_X0); bf16* X1 = (bf16*)(ws + WS_X1); bf16* X2 = (bf16*)(ws + WS_X2);
    bf16* ZA = (bf16*)(ws + WS_Z); bf16* ZU = (bf16*)(ws + WS_ZU); bf16* ACT = (bf16*)(ws + WS_Z);
    const int gw = bx * NWAVES + wid, NGW = G * NWAVES;
    float* SP8 = (float*)ws;
    LAS float* RT = (LAS float*)(lds + 131072);

    if (tid < 4) ((LAS unsigned*)(lds + 131072 + 8192 + 64))[tid] = 0u;
    __syncthreads();
    {
        LAS float* scr = (LAS float*)(lds + wid * 16384);
        for (int rep = 0; rep < REP_PRO; ++rep)
        for (int it = gw; it < a.total_items; it += NGW) {
            int di = 0;
#pragma unroll 1
            for (int j = 1; j < NCD; ++j) if (it >= a.cd[j].start) di = j;
            convert_item(a.cd[di], it - a.cd[di].start, scr, lane);
        }
        for (int i = bx * NTHREADS + tid; i < 2 * D; i += G * NTHREADS) { const float z = -a.in[10][i]; SP8[i] = -8.0f * (fmaxf(z, 0.f) + log1pf(expf(-fabsf(z)))); }
        const float* x = a.in[0];
        for (int rep = 0; rep < REP_PRO; ++rep)
        for (int m0 = gw; m0 < M; m0 += 4 * NGW) {
            f32x4 v[4][4];
#pragma unroll
            for (int r = 0; r < 4; ++r) { const int m = m0 + r * NGW; if (m < M) { const f32x4* xr = (const f32x4*)(x + (size_t)m * D) + lane;
#pragma unroll
                for (int j = 0; j < 4; ++j) v[r][j] = xr[64 * j]; } }
#pragma unroll
            for (int r = 0; r < 4; ++r) { const int m = m0 + r * NGW; if (m < M) { u32x2* hb = (u32x2*)(HB + (size_t)m * D) + lane; float s = 0.f;
#pragma unroll
                for (int j = 0; j < 4; ++j) { const f32x4 q = v[r][j]; s += (q[0] * q[0] + q[1] * q[1]) + (q[2] * q[2] + q[3] * q[3]); u32x2 w; w.x = pk_bf16(q[0], q[1]); w.y = pk_bf16(q[2], q[3]); hb[64 * j] = w; }
                s = wave_sum(s);
                if (lane < 16) SSQ[(size_t)m * 16 + lane] = (lane == 0) ? s : 0.f; } }
        }
    }
    const XcdBarrier xbar = xcd_barrier_post((unsigned*)(ws + WS_BAR), (volatile LAS unsigned*)(lds + 131072 + 8192 + 64));
#define GSYNC() do { XcdBarrier xb_ = xbar; asm volatile("" : "+s"(xb_.x)); xcd_barrier(xb_); } while (0)
    GSYNC();

    for (int l = 0; l < 4; ++l) {
        const bf16* mixA; const bf16* mixB;
        if (l < 2) {
#ifndef SKIP_INPROJ
            for (int rep = 0; rep < REP_INPROJ; ++rep) { pg8::Gemm g{HB, (const bf16*)(ws + WS_WRECIN) + (size_t)l * 2048 * D, M, 2048, D}; pg8::IdxOrder S; S.S.init(M, 2048, G, bx); S.ssq = SSQ; S.rt = RT;
              pg8::EpiInProj E{RT, X0, X1};
              pg8::gemm_phase<pg8::EpiInProj, pg8::IdxOrder, true, true>(lds, g, S, E); }
#endif
            GSYNC();
#ifndef SKIP_CONV
            for (int rep = 0; rep < REP_CONV; ++rep) { int tl = tid; asm volatile("" : "+v"(tl)); conv_phase(X1, a.in[6] + (size_t)l * 4 * D, a.in[7] + (size_t)l * D, X2, tl); }
#endif
            GSYNC();
#ifndef SKIP_GATES
            for (int rep = 0; rep < REP_GATES; ++rep) { int kg = 256; asm volatile("" : "+s"(kg)); pg8::Gemm g{X2, (const bf16*)(ws + WS_WGATES) + (size_t)l * 2048 * 256, 4 * M, 2048, kg}; pg8::GatesOrder S{G, bx};
              pg8::EpiGates E{X2, a.in[9] + (size_t)l * 2048, SP8 + (size_t)l * D, ZA, ZU};
              pg8::gemm_phase<pg8::EpiGates, pg8::GatesOrder, true, true>(lds, g, S, E); }
#endif
            GSYNC();
#ifndef SKIP_SCAN
            for (int rep = 0; rep < REP_SCAN; ++rep) { int tl = tid; asm volatile("" : "+v"(tl)); scan_phase(ZA, ZU, X0, X1, lds, tl); }
#endif
            mixA = X1; mixB = (const bf16*)(ws + WS_WRECOUT) + (size_t)l * D * D;
        } else {
#ifndef SKIP_QKVF
            if (l == 2) { int tl = tid; asm volatile("" : "+v"(tl)); f_phase(HB, SSQ, (const bf16*)(ws + WS_WQKVF) + (size_t)3072 * D, a.in[14], FL, lds, tl); }
            for (int rep = 0; rep < REP_QKVF; ++rep) { const bool first = (l == 2); const int N = first ? 3072 : D;
              pg8::Gemm g{HB, first ? (const bf16*)(ws + WS_WQKVF) : (const bf16*)(ws + WS_WQ1), M, N, D}; pg8::IdxOrder S; S.S.init(M, N, G, bx); S.ssq = SSQ; S.rt = RT;
              pg8::EpiQkvf E{RT, X0, X1, X2, FL, a.in[14]};
              pg8::gemm_phase<pg8::EpiQkvf, pg8::IdxOrder, true, true>(lds, g, S, E); }
#endif
            GSYNC();
            if (l == 2) { int tl = tid; asm volatile("" : "+v"(tl)); cphase(FL, C2, tl >> 6, tl & 63); kmax_pass(X1, (unsigned*)(ws + WS_BAR + 16384 + 1024), tl >> 6, tl & 63); GSYNC(); }
#ifndef SKIP_ATT
            for (int rep = 0; rep < REP_ATT; ++rep) { int tl = tid; asm volatile("" : "+v"(tl)); att::attn_phase(X0, X1, X2, C2, (const unsigned*)(ws + WS_BAR + 16384 + 1024), ACT, lds, tl, (unsigned*)(ws + WS_BAR + 16384) + (l - 2) * 64); }
#endif
            mixA = ACT; mixB = (const bf16*)(ws + WS_WO) + (size_t)(l - 2) * D * D;
        }
        GSYNC();
#ifndef SKIP_RES1
        { pg8::Gemm g{mixA, mixB, M, D, D}; pg8::StaticOrder S; S.init(M, D, G, bx);
          pg8::EpiRes E{HB, SSQ};
          pg8::gemm_phase<pg8::EpiRes, pg8::StaticOrder, true, true>(lds, g, S, E); }
#endif
        GSYNC();
#ifndef SKIP_FFNIN
        for (int rep = 0; rep < REP_FFNIN; ++rep) { pg8::Gemm g{HB, (const bf16*)(ws + WS_WFFNIN) + (size_t)l * 2 * FF * D, M, 2 * FF, D}; pg8::IdxOrder S; S.S.init(M, 2 * FF, G, bx); S.ssq = SSQ; S.rt = RT;
          pg8::EpiFfnIn E{RT, ACT};
          pg8::gemm_phase<pg8::EpiFfnIn, pg8::IdxOrder, true, true>(lds, g, S, E); }
#endif
        GSYNC();
#ifndef SKIP_RES2
        { pg8::Gemm g{ACT, (const bf16*)(ws + WS_WFFNOUT) + (size_t)l * D * FF, M, D, FF}; pg8::StaticOrder S; S.init(M, D, G, bx);
          pg8::EpiRes E{HB, SSQ};
          pg8::gemm_phase<pg8::EpiRes, pg8::StaticOrder, true, true>(lds, g, S, E); }
#endif
        GSYNC();
    }
    {
        const float* gn = a.in[17]; int tl = tid; asm volatile("" : "+v"(tl)); const int lane = tl & 63; const int gw = bx * NWAVES + (tl >> 6);
        for (int m0 = gw; m0 < M; m0 += 4 * NGW) {
            u32x4 w[4][2];
#pragma unroll
            for (int r = 0; r < 4; ++r) { const int m = m0 + r * NGW; if (m < M) { const u32x4* hr = (const u32x4*)(HB + (size_t)m * D) + lane; w[r][0] = hr[0]; w[r][1] = hr[64]; } }
#pragma unroll
            for (int r = 0; r < 4; ++r) { const int m = m0 + r * NGW; if (m < M) { float* orow = a.out + (size_t)m * D; float v[16]; float s = 0.f;
#pragma unroll
                for (int j = 0; j < 2; ++j)
#pragma unroll
                    for (int e = 0; e < 4; ++e) { v[8 * j + 2 * e] = __uint_as_float(w[r][j][e] << 16); v[8 * j + 2 * e + 1] = __uint_as_float(w[r][j][e] & 0xffff0000u); }
#pragma unroll
                for (int e = 0; e < 16; ++e) s += v[e] * v[e];
                const float rn = 1.0f / sqrtf(wave_sum(s) * (1.0f / D) + 1e-6f);
#pragma unroll
                for (int j = 0; j < 2; ++j) { const int c0 = 512 * j + 8 * lane; const f32x4 g0 = *(const f32x4*)(gn + c0), g1 = *(const f32x4*)(gn + c0 + 4);
                    *(f32x4*)(orow + c0) = (f32x4){v[8 * j] * rn * g0[0], v[8 * j + 1] * rn * g0[1], v[8 * j + 2] * rn * g0[2], v[8 * j + 3] * rn * g0[3]};
                    *(f32x4*)(orow + c0 + 4) = (f32x4){v[8 * j + 4] * rn * g1[0], v[8 * j + 5] * rn * g1[1], v[8 * j + 6] * rn * g1[2], v[8 * j + 7] * rn * g1[3]}; } } }
        }
    }
}

extern "C" void kernel_launch(void* const* d_in, const int* in_sizes, int n_in, void* d_out, int out_size, void* d_ws, size_t ws_size, hipStream_t stream) {
    static int grid = 0;
    if (grid == 0) {
        if (n_in != 18 || in_sizes[0] != M * D || out_size != M * D || ws_size < WS_END) { fprintf(stderr, "kernel_launch: unexpected shapes (n_in %d, in0 %d, out %d, ws %zu < %zu); nothing launched\n", n_in, n_in > 0 ? in_sizes[0] : -1, out_size, ws_size, (size_t)WS_END); grid = -1; return; }
        int dev = 0, cus = 0, per_cu = 0;
        if (hipGetDevice(&dev) != hipSuccess || hipDeviceGetAttribute(&cus, hipDeviceAttributeMultiprocessorCount, dev) != hipSuccess) { grid = -1; return; }
        if (hipFuncSetAttribute((const void*)fwd_megakernel, hipFuncAttributeMaxDynamicSharedMemorySize, LDS_BYTES) != hipSuccess) { fprintf(stderr, "kernel_launch: hipFuncSetAttribute failed\n"); grid = -1; return; }
        if (hipOccupancyMaxActiveBlocksPerMultiprocessor(&per_cu, (const void*)fwd_megakernel, NTHREADS, LDS_BYTES) != hipSuccess || per_cu < 1) { fprintf(stderr, "kernel_launch: occupancy query failed (%d)\n", per_cu); (void)hipGetLastError(); grid = -1; return; }
        grid = cus * (per_cu > 1 ? 1 : per_cu);
        if (grid < 176) { fprintf(stderr, "kernel_launch: %d CUs: the per-unit 1/rms LDS table is sized for >= 176 workgroups; nothing launched\n", grid); grid = -1; return; }
    }
    if (grid < 0) return;
    Args a{};
    for (int i = 0; i < 18; ++i) a.in[i] = (const float*)d_in[i];
    a.out = (float*)d_out; a.ws = (unsigned char*)d_ws;
    unsigned char* ws = (unsigned char*)d_ws;
    const float* norm_mix = a.in[1]; const float* norm_ffn = a.in[2]; const float* w_ffn_in = a.in[3]; const float* w_ffn_out = a.in[4]; const float* w_rec_in = a.in[5];
    const float* w_lru = a.in[8]; const float* w_rec_out = a.in[11]; const float* norm_kv = a.in[12]; const float* w_kvf = a.in[13]; const float* w_q = a.in[15]; const float* w_o = a.in[16];
    int n = 0, start = 0;
    auto add = [&](const float* W, const float* gain, bf16* WT, int ldw, int K, int groups, int half, int nvalid) {
        ConvDesc& d = a.cd[n++]; d.W = W; d.gain = gain; d.WT = WT; d.ldw = ldw; d.K = K; d.groups = groups; d.half = half; d.nvalid = nvalid; d.start = start; start += (K / 64) * groups; };
    for (int l = 0; l < 4; ++l) add(w_ffn_in + (size_t)l * D * 2 * FF, norm_ffn + l * D, (bf16*)(ws + WS_WFFNIN) + (size_t)l * 2 * FF * D, 2 * FF, D, 2 * FF / 32, FF, 2 * FF);
    for (int l = 0; l < 4; ++l) add(w_ffn_out + (size_t)l * FF * D, nullptr, (bf16*)(ws + WS_WFFNOUT) + (size_t)l * D * FF, D, FF, D / 32, 0, D);
    for (int i = 0; i < 2; ++i) add(w_rec_in + (size_t)i * D * 2048, norm_mix + i * D, (bf16*)(ws + WS_WRECIN) + (size_t)i * 2048 * D, 2048, D, 64, 0, 2048);
    for (int i = 0; i < 8; ++i) add(w_lru + (size_t)i * 256 * 512, nullptr, (bf16*)(ws + WS_WGATES) + (size_t)i * 512 * 256, 512, 256, 16, 256, 512);
    for (int i = 0; i < 2; ++i) add(w_rec_out + (size_t)i * D * D, nullptr, (bf16*)(ws + WS_WRECOUT) + (size_t)i * D * D, D, D, 32, 0, D);
    add(w_q, norm_mix + 2 * D, (bf16*)(ws + WS_WQKVF), D, D, 32, 0, D);
    add(w_kvf, norm_kv, (bf16*)(ws + WS_WQKVF) + (size_t)D * D, 2064, D, (3104 - D) / 32, 0, 2064);
    add(w_q + (size_t)D * D, norm_mix + 3 * D, (bf16*)(ws + WS_WQ1), D, D, 32, 0, D);
    for (int j = 0; j < 2; ++j) add(w_o + (size_t)j * D * D, nullptr, (bf16*)(ws + WS_WO) + (size_t)j * D * D, D, D, 32, 0, D);
    a.total_items = start; a.pad = 0;
    if (n != NCD) { fprintf(stderr, "kernel_launch: descriptor count %d != %d\n", n, NCD); return; }
    if (hipMemsetAsync((unsigned char*)d_ws + WS_BAR, 0, 16384 + 2048, stream) != hipSuccess) { fprintf(stderr, "kernel_launch: hipMemsetAsync of the barrier words failed; nothing launched\n"); return; }
    void* args[] = {&a};
    hipError_t e = hipLaunchCooperativeKernel((const void*)fwd_megakernel, dim3(grid), dim3(NTHREADS), args, LDS_BYTES, stream);
    if (e != hipSuccess) fprintf(stderr, "kernel_launch: cooperative launch failed: %s (grid %d)\n", hipGetErrorString(e), grid);
}
```

```cpp
#include <hip/hip_runtime.h>
#include <hip/hip_cooperative_groups.h>
#include <cstdio>
#include <cstdint>
namespace cg = cooperative_groups;
namespace pg8 {
#define PG8_LAS __attribute__((address_space(3)))
typedef unsigned short bf16_t;
typedef short bf16x8 __attribute__((ext_vector_type(8)));
typedef float f32x4 __attribute__((ext_vector_type(4)));
typedef unsigned u32x4 __attribute__((ext_vector_type(4)));
constexpr int BM = 256, BK = 64, HALF = 128, HTB = HALF * BK * 2  , STAGE_BYTES = 8 * HTB, NXCD = 8, WGM = 8;

__host__ __device__ __forceinline__ int lds_byte(int r, int c) { const int st = (r >> 4) * 2 + (c >> 5), rr = r & 15, cc = c & 31, ob = rr * 64 + cc * 2; return st * 1024 + (ob ^ (((ob >> 9) & 1) << 5)); }
__host__ __device__ __forceinline__ void stage_rc(int b, int& R, int& C) { const int st = b / 1024, sb = b % 1024, swz = sb ^ (((sb >> 9) & 1) << 5); R = (st >> 1) * 16 + swz / 64; C = (st & 1) * 32 + (swz % 64) / 2; }
__host__ __device__ __forceinline__ int perm32(int rho) { const int n = rho >> 4, i = rho & 15; return 8 * (i >> 2) + 4 * n + (i & 3); }

struct Unit { int pm, pn, idx; };
struct Gemm { const bf16_t* A; const bf16_t* Bt; int M, N, K; };

struct StaticOrder {
    int nM, nN, nwg, G, c;
    __host__ __device__ void init(int M, int N, int G_, int c_) { nM = M / BM; nN = N / BM; nwg = nM * nN; G = G_; c = c_; }
    __host__ __device__ bool next(int i, Unit& u) const {
        const long L = (long)i * G + c; if (L >= nwg) return false;
        int wgid = (int)L; { const int q = nwg / NXCD, r = nwg % NXCD, xcd = wgid % NXCD, off = wgid / NXCD; wgid = (xcd < r ? xcd * (q + 1) : r * (q + 1) + (xcd - r) * q) + off; }
        const int nig = WGM * nN, gid = wgid / nig, fm = gid * WGM, gsz = (nM - fm) < WGM ? (nM - fm) : WGM;
        u.pm = fm + ((wgid % nig) % gsz); u.pn = (wgid % nig) / gsz; return true;
    }
    __device__ __forceinline__ void a_ready(const Unit&) const {}
    __device__ __forceinline__ void done(const Unit&) const {}
    __device__ __forceinline__ void pre(int) const {}
};

__device__ __forceinline__ unsigned cvt_pk_bf16(float lo, float hi) { unsigned r; asm volatile("v_cvt_pk_bf16_f32 %0, %1, %2" : "=v"(r) : "v"(lo), "v"(hi)); return r; }
typedef float f32x2 __attribute__((ext_vector_type(2)));
template <class Epi, class Sched, bool ALIGN_EPI = false, bool SP2 = false>
__device__ __forceinline__ void gemm_phase(PG8_LAS unsigned char* lds, const Gemm g, const Sched& S, const Epi& E) {
    int tid_raw = threadIdx.x; asm volatile("" : "+v"(tid_raw));
    const int tid = tid_raw, wid = __builtin_amdgcn_readfirstlane(tid >> 6), lane = tid & 63, wr = wid >> 2, wc = wid & 3, fr = lane & 15, fq = lane >> 4;
    const int K = g.K, nt = K / BK;
    unsigned voffA[2], voffB[2];
#pragma unroll
    for (int i = 0; i < 2; ++i) { int R, C; stage_rc(tid * 16 + i * 8192, R, C); const int Rb = Epi::PERM ? ((R & ~31) + perm32(R & 31)) : R;
        voffA[i] = (unsigned)(R * K + C) * 2u; voffB[i] = (unsigned)(Rb * K + C) * 2u; }
    const size_t kstep = (size_t)(BK * 2);
    const size_t hstep = (size_t)HALF * K * 2;
    const size_t tstep = 2 * hstep;
    const unsigned ldsw = (unsigned)wid * 1024u;
    const int aoff = lds_byte(wr * 64 + fr, fq * 8), boff = lds_byte(wc * 32 + fr, fq * 8);
#define PG8_SA(b, h) (((b) * 2 + (h)) * HTB)
#define PG8_SB(b, h) ((4 + (b) * 2 + (h)) * HTB)
#define PG8_STAGE(bufoff, gbase, voff) do { _Pragma("unroll") for (int _i = 0; _i < 2; ++_i) \
        __builtin_amdgcn_global_load_lds((const unsigned*)((const char*)(gbase) + (voff)[_i]), (PG8_LAS unsigned*)(lds + (bufoff) + ldsw + _i * 8192), 16, 0, 0); } while (0)
#define PG8_LDA(dst, b, h) do { _Pragma("unroll") for (int m = 0; m < 4; ++m) _Pragma("unroll") for (int k = 0; k < 2; ++k) dst[m][k] = *(const PG8_LAS bf16x8*)(lds + PG8_SA(b, h) + aoff + m * 2048 + k * 1024); } while (0)
#define PG8_LDB(dst, b, h) do { _Pragma("unroll") for (int n = 0; n < 2; ++n) _Pragma("unroll") for (int k = 0; k < 2; ++k) dst[n][k] = *(const PG8_LAS bf16x8*)(lds + PG8_SB(b, h) + boff + n * 2048 + k * 1024); } while (0)
#define PG8_MMA(ai, bj, At, Bt) do { __builtin_amdgcn_s_setprio(1); _Pragma("unroll") for (int m = 0; m < 4; ++m) _Pragma("unroll") for (int n = 0; n < 2; ++n) _Pragma("unroll") for (int k = 0; k < 2; ++k) \
        acc[ai][bj][m][n] = __builtin_amdgcn_mfma_f32_16x16x32_bf16(Bt[n][k], At[m][k], acc[ai][bj][m][n], 0, 0, 0); __builtin_amdgcn_s_setprio(0); } while (0)
#define PG8_WAIT_V(n) asm volatile("s_waitcnt vmcnt(" #n ")" ::: "memory")
#define PG8_WAIT_L(n) asm volatile("s_waitcnt lgkmcnt(" #n ")" ::: "memory")
#define PG8_BAR __builtin_amdgcn_s_barrier()
#define PG8_SCHED __builtin_amdgcn_sched_barrier(0)
    Unit cur, nxt; int ui = 0;
    if (!S.next(0, cur)) return;
    f32x4 acc[2][2][4][2];
#pragma unroll
    for (int a = 0; a < 2; ++a)
#pragma unroll
        for (int b = 0; b < 2; ++b)
#pragma unroll
            for (int m = 0; m < 4; ++m)
#pragma unroll
                for (int n = 0; n < 2; ++n) acc[a][b][m][n] = (f32x4){0.f, 0.f, 0.f, 0.f};
    bf16x8 At[4][2], B0[2][2], B1[2][2];
    const char* cA = (const char*)g.A + (size_t)cur.pm * tstep; const char* cB = (const char*)g.Bt + (size_t)cur.pn * tstep;
    S.a_ready(cur);
    if constexpr (SP2) {
        PG8_STAGE(PG8_SB(0, 0), cB, voffB); PG8_STAGE(PG8_SB(0, 1), cB + hstep, voffB); PG8_STAGE(PG8_SA(0, 0), cA, voffA); PG8_STAGE(PG8_SA(0, 1), cA + hstep, voffA);
        S.pre(tid);
        if (wr == 1) PG8_BAR;
        PG8_WAIT_V(2); PG8_BAR;
        PG8_STAGE(PG8_SB(1, 0), cB + kstep, voffB); PG8_STAGE(PG8_SA(1, 0), cA + kstep, voffA); PG8_STAGE(PG8_SB(1, 1), cB + hstep + kstep, voffB);
        PG8_WAIT_V(6); PG8_BAR;
    } else {
        PG8_STAGE(PG8_SB(0, 0), cB, voffB); PG8_STAGE(PG8_SA(0, 0), cA, voffA); PG8_STAGE(PG8_SB(0, 1), cB + hstep, voffB); PG8_STAGE(PG8_SA(0, 1), cA + hstep, voffA);
        if (wr == 1) PG8_BAR;
        PG8_WAIT_V(4); PG8_BAR;
        PG8_STAGE(PG8_SB(1, 0), cB + kstep, voffB); PG8_STAGE(PG8_SA(1, 0), cA + kstep, voffA); PG8_STAGE(PG8_SB(1, 1), cB + hstep + kstep, voffB);
        PG8_WAIT_V(6); PG8_BAR;
    }
    for (;;) {
        const bool has_next = S.next(ui + 1, nxt);
        const char* nA = has_next ? (const char*)g.A + (size_t)nxt.pm * tstep : cA; const char* nB = has_next ? (const char*)g.Bt + (size_t)nxt.pn * tstep : cB;
        for (int t = 0; t < nt; t += 2) {
            const bool last = (t == nt - 2);
            const char* a1 = cA + (size_t)(t + 1) * kstep;
            const char* a2 = last ? nA : cA + (size_t)(t + 2) * kstep; const char* b2 = last ? nB : cB + (size_t)(t + 2) * kstep;
            const char* a3 = a2 + kstep; const char* b3 = b2 + kstep;
            if (last && has_next) S.a_ready(nxt);
            if constexpr (SP2) {
            PG8_LDB(B0, 0, 0); PG8_LDB(B1, 0, 1); PG8_SCHED; PG8_LDA(At, 0, 0); PG8_STAGE(PG8_SA(1, 1), a1 + hstep, voffA);
            PG8_WAIT_V(8); PG8_WAIT_L(0); PG8_BAR; PG8_MMA(0, 0, At, B0); PG8_MMA(0, 1, At, B1); PG8_BAR; PG8_SCHED;
            PG8_LDA(At, 0, 1); PG8_STAGE(PG8_SB(0, 0), b2, voffB); PG8_STAGE(PG8_SB(0, 1), b2 + hstep, voffB); PG8_STAGE(PG8_SA(0, 0), a2, voffA);
            PG8_WAIT_V(8); PG8_WAIT_L(0); PG8_BAR; PG8_MMA(1, 0, At, B0); PG8_MMA(1, 1, At, B1); PG8_BAR; PG8_SCHED;
            PG8_LDB(B0, 1, 0); PG8_LDB(B1, 1, 1); PG8_SCHED; PG8_LDA(At, 1, 0); PG8_STAGE(PG8_SA(0, 1), a2 + hstep, voffA);
            PG8_WAIT_V(8); PG8_WAIT_L(0); PG8_BAR; PG8_MMA(0, 0, At, B0); PG8_MMA(0, 1, At, B1); PG8_BAR; PG8_SCHED;
            PG8_LDA(At, 1, 1); PG8_STAGE(PG8_SB(1, 0), b3, voffB); PG8_STAGE(PG8_SB(1, 1), b3 + hstep, voffB); PG8_STAGE(PG8_SA(1, 0), a3, voffA);
            PG8_WAIT_V(8); PG8_WAIT_L(0); PG8_BAR; PG8_MMA(1, 0, At, B0); PG8_MMA(1, 1, At, B1); PG8_BAR; PG8_SCHED;
            } else {
            PG8_LDB(B0, 0, 0); PG8_SCHED; PG8_LDA(At, 0, 0); PG8_STAGE(PG8_SA(1, 1), a1 + hstep, voffA);
            PG8_WAIT_L(8); PG8_BAR; PG8_WAIT_L(0); PG8_MMA(0, 0, At, B0); PG8_BAR; PG8_SCHED;
            PG8_LDB(B1, 0, 1); PG8_STAGE(PG8_SB(0, 0), b2, voffB);
            PG8_BAR; PG8_WAIT_L(0); PG8_MMA(0, 1, At, B1); PG8_BAR;
            PG8_LDA(At, 0, 1); PG8_STAGE(PG8_SA(0, 0), a2, voffA);
            PG8_BAR; PG8_WAIT_L(0); PG8_MMA(1, 0, At, B0); PG8_BAR; PG8_SCHED;
            PG8_STAGE(PG8_SB(0, 1), b2 + hstep, voffB);
            PG8_WAIT_V(6); PG8_BAR; PG8_MMA(1, 1, At, B1); PG8_BAR;
            PG8_LDB(B0, 1, 0); PG8_SCHED; PG8_LDA(At, 1, 0); PG8_STAGE(PG8_SA(0, 1), a2 + hstep, voffA);
            PG8_WAIT_L(8); PG8_BAR; PG8_WAIT_L(0); PG8_MMA(0, 0, At, B0); PG8_BAR; PG8_SCHED;
            PG8_LDB(B1, 1, 1); PG8_STAGE(PG8_SB(1, 0), b3, voffB);
            PG8_BAR; PG8_WAIT_L(0); PG8_MMA(0, 1, At, B1); PG8_BAR;
            PG8_LDA(At, 1, 1); PG8_STAGE(PG8_SA(1, 0), a3, voffA);
            PG8_BAR; PG8_WAIT_L(0); PG8_MMA(1, 0, At, B0); PG8_BAR; PG8_SCHED;
            PG8_STAGE(PG8_SB(1, 1), b3 + hstep, voffB);
            PG8_WAIT_V(6); PG8_BAR; PG8_MMA(1, 1, At, B1); PG8_BAR;
            }
        }
        if constexpr (ALIGN_EPI) { if (wr == 0) PG8_BAR; }
        if constexpr (!Epi::AFTER_DRAIN) { E(acc, cur, wr, wc, fr, fq); S.done(cur); }
        if (!has_next) break;
#pragma unroll
        for (int a = 0; a < 2; ++a)
#pragma unroll
            for (int b = 0; b < 2; ++b)
#pragma unroll
                for (int m = 0; m < 4; ++m)
#pragma unroll
                    for (int n = 0; n < 2; ++n) acc[a][b][m][n] = (f32x4){0.f, 0.f, 0.f, 0.f};
        cur = nxt; cA = nA; cB = nB; ++ui;
        if constexpr (ALIGN_EPI) { if (wr == 1) PG8_BAR; }
    }
    PG8_WAIT_V(0);
    if constexpr (!ALIGN_EPI) { if (wr == 0) PG8_BAR; }
    PG8_BAR;
    if constexpr (Epi::AFTER_DRAIN) { E.fused(acc, cur, wr, wc, fr, fq, lds, wid, lane); S.done(cur); }
#undef PG8_SA
#undef PG8_SB
#undef PG8_STAGE
#undef PG8_LDA
#undef PG8_LDB
#undef PG8_MMA
#undef PG8_WAIT_V
#undef PG8_WAIT_L
#undef PG8_BAR
#undef PG8_SCHED
}
}
namespace pg8 {
typedef unsigned u32x2 __attribute__((ext_vector_type(2)));
constexpr int MTOK = 16384, DM = 1024, DFF = 2816, SEQL = 2048;
__device__ __forceinline__ float sigmoid_f(float x) { return __builtin_amdgcn_rcpf(1.f + __expf(-x)); }
__device__ __forceinline__ float gelu_tanh_f(float x) { return x * sigmoid_f(1.5957691216057308f * (x + 0.044715f * x * x * x)); }
__device__ __forceinline__ f32x4 gelu4(f32x4 x) { const f32x4 t = x * ((x * x) * -0.10294324f + -2.3022082f); f32x4 ex;
    ex[0] = __builtin_amdgcn_exp2f(t[0]); ex[1] = __builtin_amdgcn_exp2f(t[1]); ex[2] = __builtin_amdgcn_exp2f(t[2]); ex[3] = __builtin_amdgcn_exp2f(t[3]);
    const f32x4 d = ex + 1.0f; f32x4 q; q[0] = __builtin_amdgcn_rcpf(d[0]); q[1] = __builtin_amdgcn_rcpf(d[1]); q[2] = __builtin_amdgcn_rcpf(d[2]); q[3] = __builtin_amdgcn_rcpf(d[3]);
    return x * q; }
__device__ __forceinline__ float bf2f(unsigned short v) { return __uint_as_float((unsigned)v << 16); }
typedef const PG8_LAS float* rtab_t;
template <class Sched> __device__ __forceinline__ void fill_rinv(const Sched& S, const float* ssq, PG8_LAS float* rt, int tid) {
    asm volatile("" : "+v"(tid));
    PG8_LAS int* pml = (PG8_LAS int*)(rt + 8 * 256);
    if (tid < 8) { Unit u; u.pm = -1; pml[tid] = S.next(tid, u) ? u.pm : -1; }
    __syncthreads();
    f32x4 p[4][4]; int pmv[4];
#pragma unroll
    for (int k = 0; k < 4; ++k) { const int idx = tid + 512 * k; pmv[k] = pml[idx >> 8];
        if (pmv[k] >= 0) { const f32x4* q = (const f32x4*)(ssq + (size_t)(pmv[k] * BM + (idx & 255)) * 16); p[k][0] = q[0]; p[k][1] = q[1]; p[k][2] = q[2]; p[k][3] = q[3]; } }
#pragma unroll
    for (int k = 0; k < 4; ++k) if (pmv[k] >= 0) { const f32x4 a = (p[k][0] + p[k][1]) + (p[k][2] + p[k][3]); rt[tid + 512 * k] = __builtin_amdgcn_rsqf(((a[0] + a[1]) + (a[2] + a[3])) * (1.0f / DM) + 1e-6f); }
    __syncthreads();
}
struct IdxOrder { StaticOrder S; const float* ssq; PG8_LAS float* rt;
    __device__ __forceinline__ bool next(int i, Unit& u) const { u.idx = i; return S.next(i, u); }
    __device__ __forceinline__ void a_ready(const Unit&) const {}
    __device__ __forceinline__ void done(const Unit&) const {}
    __device__ __forceinline__ void pre(int tid) const { fill_rinv(*this, ssq, rt, tid); }
};
__device__ __forceinline__ size_t blk_off(int row, int ch) { const int b = row >> 11, t = row & (SEQL - 1); return ((((size_t)(b * 64 + (ch >> 4)) * 8 + (t & 7)) * 256 + (t >> 3)) * 16 + (ch & 15)); }
#define PG8_FENCE do { asm volatile("" ::: "memory"); __builtin_amdgcn_sched_barrier(0); } while (0)
struct EpiInProj {
    static constexpr bool PERM = true, AFTER_DRAIN = false;
    rtab_t rt; bf16_t* G; bf16_t* REC;
    __device__ __forceinline__ void operator()(const f32x4 (&acc)[2][2][4][2], const Unit& u, int wr, int wc, int fr, int fq) const {
        asm volatile("" : "+v"(fr), "+v"(fq));
        const int row0 = u.pm * BM + wr * 64 + fr; rtab_t rr = rt + u.idx * 256 + wr * 64 + fr;
        const bool isg = u.pn < 4; const int col0 = (u.pn & 3) * BM + wc * 32 + 8 * fq;
#pragma unroll
        for (int ai = 0; ai < 2; ++ai)
#pragma unroll
            for (int m = 0; m < 4; ++m) { const int row = row0 + ai * HALF + m * 16; const float r = rr[ai * HALF + m * 16];
#pragma unroll
                for (int bj = 0; bj < 2; ++bj) { f32x4 v0 = acc[ai][bj][m][0] * r, v1 = acc[ai][bj][m][1] * r;
                    if (isg) { v0 = gelu4(v0); v1 = gelu4(v1); }
                    u32x4 w; w.x = cvt_pk_bf16(v0[0], v0[1]); w.y = cvt_pk_bf16(v0[2], v0[3]); w.z = cvt_pk_bf16(v1[0], v1[1]); w.w = cvt_pk_bf16(v1[2], v1[3]);
                    bf16_t* dst = isg ? G + blk_off(row, col0 + bj * HALF) : REC + (size_t)row * DM + col0 + bj * HALF;
                    *(u32x4*)dst = w; } if (m & 1) PG8_FENCE; }
    }
};
struct EpiGates {
    static constexpr bool PERM = true, AFTER_DRAIN = false;
    const bf16_t* RECC; const float* bg; const float* sp8t; bf16_t* LA; bf16_t* UP;
    __device__ __forceinline__ void operator()(const f32x4 (&acc)[2][2][4][2], const Unit& u, int wr, int wc, int fr, int fq) const {
        asm volatile("" : "+v"(fr), "+v"(fq));
        const int n = u.pm >> 6, pm = u.pm & 63, pnl = u.pn & 1; const int row0 = pm * BM + wr * 64 + fr;
        u32x2 xall[2][2][4];
#pragma unroll
        for (int nn = 0; nn < 2; ++nn)
#pragma unroll
            for (int ai = 0; ai < 2; ++ai)
#pragma unroll
                for (int m = 0; m < 4; ++m) xall[nn][ai][m] = *(const u32x2*)(RECC + ((size_t)n * MTOK + row0 + ai * HALF + m * 16) * 256 + pnl * HALF + wc * 32 + 8 * fq + 4 * nn);
#pragma unroll
        for (int nn = 0; nn < 2; ++nn) { const int cl0 = pnl * HALF + wc * 32 + 8 * fq + 4 * nn;
            const f32x4 bi = *(const f32x4*)(bg + n * 512 + cl0), br = *(const f32x4*)(bg + n * 512 + 256 + cl0), sp = *(const f32x4*)(sp8t + n * 256 + cl0);
#pragma unroll
            for (int ai = 0; ai < 2; ++ai)
#pragma unroll
                for (int m = 0; m < 4; ++m) { const int row = row0 + ai * HALF + m * 16;
                    const u32x2 xr = xall[nn][ai][m];
                    f32x4 ti = (acc[ai][0][m][nn] + bi) * -1.4426950408889634f, tr = (acc[ai][1][m][nn] + br) * -1.4426950408889634f, ei, er;
#pragma unroll
                    for (int j = 0; j < 4; ++j) { ei[j] = __builtin_amdgcn_exp2f(fminf(ti[j], 57.f)); er[j] = __builtin_amdgcn_exp2f(fminf(tr[j], 57.f)); }
                    ei = ei + 1.0f; er = er + 1.0f; const f32x4 pr = ei * er; f32x4 rc;
                    rc[0] = __builtin_amdgcn_rcpf(pr[0]); rc[1] = __builtin_amdgcn_rcpf(pr[1]); rc[2] = __builtin_amdgcn_rcpf(pr[2]); rc[3] = __builtin_amdgcn_rcpf(pr[3]);
                    const f32x4 xv = {__uint_as_float(xr[0] << 16), __uint_as_float(xr[0] & 0xffff0000u), __uint_as_float(xr[1] << 16), __uint_as_float(xr[1] & 0xffff0000u)};
                    const f32x4 lav = sp * (ei * rc), uv = xv * (er * rc);
                    const size_t off = blk_off(row, n * 256 + cl0);
                    u32x2 w0; w0.x = cvt_pk_bf16(lav[0], lav[1]); w0.y = cvt_pk_bf16(lav[2], lav[3]); *(u32x2*)(LA + off) = w0;
                    u32x2 w; w.x = cvt_pk_bf16(uv[0], uv[1]); w.y = cvt_pk_bf16(uv[2], uv[3]); *(u32x2*)(UP + off) = w; if (m & 1) PG8_FENCE; } }
    }
};
struct EpiRes {
    static constexpr bool PERM = true, AFTER_DRAIN = false;
    bf16_t* HB; float* SSQ;
    __device__ __forceinline__ void operator()(const f32x4 (&acc)[2][2][4][2], const Unit& u, int wr, int wc, int fr, int fq) const {
        asm volatile("" : "+v"(fr), "+v"(fq));
        const int row0 = u.pm * BM + wr * 64 + fr, col0 = u.pn * BM + wc * 32 + 8 * fq;
#pragma unroll
        for (int ai = 0; ai < 2; ++ai) {
            u32x4 old[4][2];
#pragma unroll
            for (int m = 0; m < 4; ++m)
#pragma unroll
                for (int bj = 0; bj < 2; ++bj) old[m][bj] = *(const u32x4*)(HB + (size_t)(row0 + ai * HALF + m * 16) * DM + col0 + bj * HALF);
#pragma unroll
            for (int m = 0; m < 4; ++m) { const int row = row0 + ai * HALF + m * 16; float s = 0.f;
#pragma unroll
                for (int bj = 0; bj < 2; ++bj) { bf16_t* p = HB + (size_t)row * DM + col0 + bj * HALF; float h[8];
#pragma unroll
                    for (int j = 0; j < 8; ++j) { const unsigned w = old[m][bj][j >> 1]; h[j] = ((j & 1) ? __uint_as_float(w & 0xffff0000u) : __uint_as_float(w << 16)) + acc[ai][bj][m][j >> 2][j & 3]; s += h[j] * h[j]; }
                    u32x4 o; o.x = cvt_pk_bf16(h[0], h[1]); o.y = cvt_pk_bf16(h[2], h[3]); o.z = cvt_pk_bf16(h[4], h[5]); o.w = cvt_pk_bf16(h[6], h[7]);
                    *(u32x4*)p = o; }
                s += __shfl_xor(s, 16); s += __shfl_xor(s, 32);
                if (fq == 0) SSQ[(size_t)row * 16 + u.pn * 4 + wc] = s; }
            PG8_FENCE; }
    }
};
struct EpiFfnIn {
    static constexpr bool PERM = true, AFTER_DRAIN = false;
    rtab_t rt; bf16_t* ACT;
    __device__ __forceinline__ void operator()(const f32x4 (&acc)[2][2][4][2], const Unit& u, int wr, int wc, int fr, int fq) const {
        asm volatile("" : "+v"(fr), "+v"(fq));
        const int row0 = u.pm * BM + wr * 64 + fr; rtab_t rr = rt + u.idx * 256 + wr * 64 + fr;
        const int col0 = u.pn * HALF + wc * 32 + 8 * fq;
#pragma unroll
        for (int ai = 0; ai < 2; ++ai)
#pragma unroll
            for (int m = 0; m < 4; ++m) { const float r = rr[ai * HALF + m * 16]; const float r2 = r * -1.4426950408889634f, rq = r * r;
                f32x4 v[2];
#pragma unroll
                for (int nn = 0; nn < 2; ++nn) { const f32x4 g = acc[ai][0][m][nn], up = acc[ai][1][m][nn]; const f32x4 t = g * r2; f32x4 ex;
                    ex[0] = __builtin_amdgcn_exp2f(t[0]); ex[1] = __builtin_amdgcn_exp2f(t[1]); ex[2] = __builtin_amdgcn_exp2f(t[2]); ex[3] = __builtin_amdgcn_exp2f(t[3]);
                    const f32x4 d = ex + 1.0f; f32x4 q; q[0] = __builtin_amdgcn_rcpf(d[0]); q[1] = __builtin_amdgcn_rcpf(d[1]); q[2] = __builtin_amdgcn_rcpf(d[2]); q[3] = __builtin_amdgcn_rcpf(d[3]);
                    v[nn] = (g * up) * (q * rq); }
                u32x4 w; w.x = cvt_pk_bf16(v[0][0], v[0][1]); w.y = cvt_pk_bf16(v[0][2], v[0][3]); w.z = cvt_pk_bf16(v[1][0], v[1][1]); w.w = cvt_pk_bf16(v[1][2], v[1][3]);
                *(u32x4*)(ACT + (size_t)(row0 + ai * HALF + m * 16) * DFF + col0) = w; if (m & 1) PG8_FENCE; }
    }
};
struct EpiQkvf {
    static constexpr bool PERM = true, AFTER_DRAIN = false;
    rtab_t rt; bf16_t* Q; bf16_t* K; bf16_t* VT; float* FL; const float* bf;
    __device__ __forceinline__ void operator()(const f32x4 (&acc)[2][2][4][2], const Unit& u, int wr, int wc, int fr, int fq) const {
        asm volatile("" : "+v"(fr), "+v"(fq));
        const int row0 = u.pm * BM + wr * 64 + fr; rtab_t rr = rt + u.idx * 256 + wr * 64 + fr;
        const int grp = u.pn >> 2, col0 = (u.pn & 3) * BM + wc * 32 + 8 * fq;
        if (grp < 2) { bf16_t* base = grp == 0 ? Q : K; const float sc = grp == 0 ? 0.125f * 1.4426950408889634f : 1.0f;
#pragma unroll
            for (int ai = 0; ai < 2; ++ai)
#pragma unroll
                for (int m = 0; m < 4; ++m) { bf16_t* rowp = base + (size_t)(row0 + ai * HALF + m * 16) * DM + col0; const float r = rr[ai * HALF + m * 16] * sc;
#pragma unroll
                    for (int bj = 0; bj < 2; ++bj) { const f32x4 v0 = acc[ai][bj][m][0] * r, v1 = acc[ai][bj][m][1] * r;
                        u32x4 w; w.x = cvt_pk_bf16(v0[0], v0[1]); w.y = cvt_pk_bf16(v0[2], v0[3]); w.z = cvt_pk_bf16(v1[0], v1[1]); w.w = cvt_pk_bf16(v1[2], v1[3]);
                        *(u32x4*)(rowp + bj * HALF) = w; } }
        } else if (grp == 2) {
#pragma unroll
            for (int ai = 0; ai < 2; ++ai)
#pragma unroll
                for (int m = 0; m < 4; ++m) { const int row = row0 + ai * HALF + m * 16; const int b = row >> 11, t = row & (SEQL - 1); const float r = rr[ai * HALF + m * 16];
#pragma unroll
                    for (int bj = 0; bj < 2; ++bj)
#pragma unroll
                        for (int j = 0; j < 8; ++j) { const int col = col0 + bj * HALF + j;
                            const unsigned w = cvt_pk_bf16(acc[ai][bj][m][j >> 2][j & 3] * r, 0.f);
                            VT[((size_t)b * DM + col) * SEQL + t] = (bf16_t)(w & 0xffffu); } }
        }
    }
};
struct GatesOrder {
    int G, c;
    __device__ __forceinline__ bool next(int i, Unit& u) const { const int L = i * G + c; if (L >= 512) return false; const int n = L >> 7, rem = L & 127; u.pm = n * 64 + (rem >> 1); u.pn = n * 2 + (rem & 1); return true; }
    __device__ __forceinline__ void a_ready(const Unit&) const {}
    __device__ __forceinline__ void done(const Unit&) const {}
    __device__ __forceinline__ void pre(int) const {}
};
}
#define LAS __attribute__((address_space(3)))
typedef unsigned short bf16;
typedef float f32x4 __attribute__((ext_vector_type(4)));
typedef float f32x16 __attribute__((ext_vector_type(16)));
typedef unsigned u32x4 __attribute__((ext_vector_type(4)));
typedef unsigned u32x2 __attribute__((ext_vector_type(2)));
typedef short bf16x8 __attribute__((ext_vector_type(8)));
constexpr int M = 16384, D = 1024, SEQ = 2048, NB = 8, NH = 16, FF = 2816, NQKVF = 3328;
constexpr int NTHREADS = 512, NWAVES = 8, LDS_BYTES = 147456;
constexpr size_t MiB = 1u << 20;
constexpr size_t WS_WRECIN = 1 * MiB, WS_WGATES = 9 * MiB, WS_WRECOUT = 11 * MiB, WS_WFFNIN = 15 * MiB, WS_WFFNOUT = 59 * MiB, WS_WQKVF = 81 * MiB, WS_WQ1 = 88 * MiB, WS_WO = 90 * MiB;
constexpr size_t WS_HB = 94 * MiB, WS_SSQ = 126 * MiB, WS_FL = 127 * MiB, WS_C2 = 128 * MiB, WS_X0 = 129 * MiB, WS_X1 = 161 * MiB, WS_X2 = 193 * MiB, WS_Z = 225 * MiB, WS_ZU = 289 * MiB, WS_END = 321 * MiB;
constexpr size_t WS_BAR = 65536;
constexpr int NCD = 25;
struct ConvDesc { const float* W; const float* gain; bf16* WT; int ldw, K, groups, half, nvalid, start; };
struct Args { const float* in[18]; float* out; unsigned char* ws; ConvDesc cd[NCD]; int total_items; int pad; };

__device__ __forceinline__ unsigned pk_bf16(float lo, float hi) { return pg8::cvt_pk_bf16(lo, hi); }
__device__ __forceinline__ float wave_sum(float v) {
#pragma unroll
    for (int o = 1; o < 64; o <<= 1) v += __shfl_xor(v, o);
    return v;
}
#define XB_TMO      128
#define XB_XCNT(j)  (256  + 64 * (j))
#define XB_XSUB(j)  (1280 + 64 * (j))
#define XB_XGEN(j)  (2304 + 64 * (j))
#define XB_TOP      3328
#define XB_TOPGEN   3392
#define XCD_BAR_WORDS 3456
#define XB_SPIN_CAP (1u << 18)

__device__ __forceinline__ unsigned xb_ld(unsigned* p)              { return __hip_atomic_load(p, __ATOMIC_RELAXED, __HIP_MEMORY_SCOPE_AGENT); }
__device__ __forceinline__ unsigned xb_add(unsigned* p, unsigned v) { return __hip_atomic_fetch_add(p, v, __ATOMIC_RELAXED, __HIP_MEMORY_SCOPE_AGENT); }
__device__ __forceinline__ unsigned xb_xcc_id() { return (unsigned)__builtin_amdgcn_s_getreg((3 << 11) | 20) & 0xFu; }
#define XB_SPIN(cond, bar) do { unsigned _sp = 0; while (cond) { __builtin_amdgcn_s_sleep(1); \
    if ((++_sp & 255u) == 0u) { if (xb_ld(&(bar)[XB_TMO])) break; if (_sp > XB_SPIN_CAP) { atomicAdd(&(bar)[XB_TMO], 1u); break; } } } } while (0)

struct XcdBarrier {
    unsigned* bar; unsigned x;
    volatile LAS unsigned* st;
};

__device__ __forceinline__ XcdBarrier xcd_barrier_post(unsigned* bar, volatile LAS unsigned* st) {
    XcdBarrier b; b.bar = bar; b.x = xb_xcc_id(); b.st = st;
    if (threadIdx.x == 0) (void)xb_add(&bar[XB_XCNT(b.x)], 1u);
    return b;
}
__device__ __forceinline__ void xcd_barrier_complete(unsigned* bar, unsigned x, unsigned& nloc, unsigned& nx) {
    const unsigned G = gridDim.x * gridDim.y * gridDim.z;
    unsigned sum, cnt, mine, sp = 0u;
    for (;;) {
        sum = 0u; cnt = 0u; mine = 0u;
#pragma unroll
        for (unsigned j = 0; j < 16; ++j) { const unsigned c = xb_ld(&bar[XB_XCNT(j)]); sum += c; cnt += (c > 0u) ? 1u : 0u; mine = (j == x) ? c : mine; }
        if (sum == G) break;
        __builtin_amdgcn_s_sleep(1);
        if ((++sp & 255u) == 0u) { if (xb_ld(&bar[XB_TMO])) break; if (sp > XB_SPIN_CAP) { atomicAdd(&bar[XB_TMO], 1u); break; } }
    }
    nloc = mine > 0u ? mine : 1u; nx = cnt > 0u ? cnt : 1u;
}

__device__ __forceinline__ void xcd_barrier(const XcdBarrier& b) {
    asm volatile("s_waitcnt vmcnt(0)" ::: "memory");
    __syncthreads();
    if (threadIdx.x == 0) {
        unsigned* bar = b.bar;
        __builtin_amdgcn_s_waitcnt(0);
        unsigned nloc = b.st[0], nx = b.st[1];
        if (nloc == 0u) { xcd_barrier_complete(bar, b.x, nloc, nx); b.st[0] = nloc; b.st[1] = nx; }
        const unsigned old = xb_add(&bar[XB_XSUB(b.x)], 1u);
        const unsigned gen = old / nloc;
        if (old + 1u == (gen + 1u) * nloc) {
            __builtin_amdgcn_fence(__ATOMIC_RELEASE, "agent");
            asm volatile("s_waitcnt vmcnt(0)" ::: "memory");
            const unsigned og = xb_add(&bar[XB_TOP], 1u);
            const unsigned tg = og / nx;
            if (og + 1u == (tg + 1u) * nx) xb_add(&bar[XB_TOPGEN], 1u);
            else XB_SPIN(xb_ld(&bar[XB_TOPGEN]) == tg, bar);
            __builtin_amdgcn_fence(__ATOMIC_ACQUIRE, "agent");
            xb_add(&bar[XB_XGEN(b.x)], 1u);
            asm volatile("s_waitcnt vmcnt(0)" ::: "memory");
        } else {
            XB_SPIN(xb_ld(&bar[XB_XGEN(b.x)]) == gen, bar);
            __builtin_amdgcn_fence(__ATOMIC_ACQUIRE, "agent");
            asm volatile("s_waitcnt vmcnt(0)" ::: "memory");
        }
    }
    __syncthreads();
}
__device__ __forceinline__ void convert_item(const ConvDesc& d, int item, LAS float* scr, int lane) {
    const int kb = item / d.groups, g = item - kb * d.groups, k0 = 64 * kb, n0 = 32 * g;
    int sc0 = n0; if (d.half) { const int pn = n0 >> 8, bj = (n0 >> 7) & 1, jj = n0 & 127; sc0 = bj * d.half + 128 * pn + jj; }
    const int c = lane & 31; const bool valid = (sc0 + c) < d.nvalid;
    float v[32];
#pragma unroll
    for (int i = 0; i < 32; ++i) { const int kk = 2 * i + (lane >> 5); v[i] = valid ? d.W[(size_t)(k0 + kk) * d.ldw + sc0 + c] : 0.f; }
    if (d.gain) {
#pragma unroll
        for (int i = 0; i < 32; ++i) v[i] *= d.gain[k0 + 2 * i + (lane >> 5)]; }
#pragma unroll
    for (int i = 0; i < 32; ++i) scr[(2 * i + (lane >> 5)) * 33 + c] = v[i];
    asm volatile("s_waitcnt lgkmcnt(0)" ::: "memory");
    const int ch = lane & 7;
#pragma unroll
    for (int j = 0; j < 4; ++j) { const int n = (lane >> 3) + 8 * j; const LAS float* s = scr + (8 * ch) * 33 + n;
        u32x4 o; o.x = pk_bf16(s[0 * 33], s[1 * 33]); o.y = pk_bf16(s[2 * 33], s[3 * 33]); o.z = pk_bf16(s[4 * 33], s[5 * 33]); o.w = pk_bf16(s[6 * 33], s[7 * 33]);
        *(u32x4*)(d.WT + (size_t)(n0 + n) * d.K + k0 + 8 * ch) = o; }
    asm volatile("s_waitcnt lgkmcnt(0)" ::: "memory");
}
__device__ __forceinline__ void conv_phase(const bf16* REC, const float* cw, const float* cb, bf16* RECC, int tid) {
    for (int it = blockIdx.x * NTHREADS + tid; it < 128 * 1024; it += gridDim.x * NTHREADS) {
        const int c = it & 127, run = it >> 7, tok0 = run * 16; const bool first = (tok0 & (SEQ - 1)) == 0;
        float w[4][8], bb[8], x0[8], x1[8], x2[8];
#pragma unroll
        for (int tp = 0; tp < 4; ++tp) { const f32x4 a = *(const f32x4*)(cw + tp * D + c * 8), b = *(const f32x4*)(cw + tp * D + c * 8 + 4);
            w[tp][0] = a[0]; w[tp][1] = a[1]; w[tp][2] = a[2]; w[tp][3] = a[3]; w[tp][4] = b[0]; w[tp][5] = b[1]; w[tp][6] = b[2]; w[tp][7] = b[3]; }
        { const f32x4 a = *(const f32x4*)(cb + c * 8), b = *(const f32x4*)(cb + c * 8 + 4); bb[0] = a[0]; bb[1] = a[1]; bb[2] = a[2]; bb[3] = a[3]; bb[4] = b[0]; bb[5] = b[1]; bb[6] = b[2]; bb[7] = b[3]; }
        const bf16* src = REC + (size_t)tok0 * D + c * 8;
        u32x4 r0 = {0u, 0u, 0u, 0u}, r1 = r0, r2 = r0;
        if (!first) { r0 = *(const u32x4*)(src - 3 * D); r1 = *(const u32x4*)(src - 2 * D); r2 = *(const u32x4*)(src - D); }
#pragma unroll
        for (int j = 0; j < 4; ++j) { x0[2 * j] = __uint_as_float(r0[j] << 16); x0[2 * j + 1] = __uint_as_float(r0[j] & 0xffff0000u);
            x1[2 * j] = __uint_as_float(r1[j] << 16); x1[2 * j + 1] = __uint_as_float(r1[j] & 0xffff0000u);
            x2[2 * j] = __uint_as_float(r2[j] << 16); x2[2 * j + 1] = __uint_as_float(r2[j] & 0xffff0000u); }
        bf16* dst = RECC + ((size_t)(c >> 5) * M + tok0) * 256 + (c & 31) * 8;
#pragma unroll
        for (int i = 0; i < 16; ++i) { const u32x4 rc = *(const u32x4*)(src + (size_t)i * D); float xc[8], y[8];
#pragma unroll
            for (int j = 0; j < 4; ++j) { xc[2 * j] = __uint_as_float(rc[j] << 16); xc[2 * j + 1] = __uint_as_float(rc[j] & 0xffff0000u); }
#pragma unroll
            for (int j = 0; j < 8; ++j) { y[j] = bb[j] + w[0][j] * x0[j] + w[1][j] * x1[j] + w[2][j] * x2[j] + w[3][j] * xc[j]; x0[j] = x1[j]; x1[j] = x2[j]; x2[j] = xc[j]; }
            u32x4 o; o.x = pk_bf16(y[0], y[1]); o.y = pk_bf16(y[2], y[3]); o.z = pk_bf16(y[4], y[5]); o.w = pk_bf16(y[6], y[7]);
            *(u32x4*)(dst + (size_t)i * 256) = o; }
    }
}
__device__ __forceinline__ void scan_phase(const bf16* LA, const bf16* UP, const bf16* G, bf16* Y, LAS unsigned char* lds, int tid) {
    LAS float* sW = (LAS float*)lds;
    const int lane = tid & 63, wid = tid >> 6, hf = tid & 1, c = tid >> 1, cw = lane >> 1;
    for (int item = 2 * blockIdx.x; item < 512; item += 2 * gridDim.x)
#pragma unroll 1
    for (int sub = 0; sub < 2; ++sub) {
        const int it = item + sub, b = it >> 6, cg = it & 63;
        const size_t base = ((size_t)b * SEQ + c * 8) * D + cg * 16 + hf * 8;
        const size_t bb = ((size_t)(b * 64 + cg) * 8 * 256 + c) * 16 + hf * 8;
        u32x4 ll[8], uu[8], gg[8];
#pragma unroll
        for (int i = 0; i < 8; ++i) { ll[i] = *(const u32x4*)(LA + bb + (size_t)i * 4096); uu[i] = *(const u32x4*)(UP + bb + (size_t)i * 4096); gg[i] = *(const u32x4*)(G + bb + (size_t)i * 4096); }
        float av[8][8];
        float P[8], H[8];
#pragma unroll
        for (int j = 0; j < 8; ++j) { P[j] = 1.f; H[j] = 0.f; }
#pragma unroll
        for (int i = 0; i < 8; ++i)
#pragma unroll
            for (int j = 0; j < 8; ++j) { const unsigned lw = ll[i][j >> 1]; const float la = (j & 1) ? __uint_as_float(lw & 0xffff0000u) : __uint_as_float(lw << 16);
                const float a = __expf(la); av[i][j] = a; const float mult = __builtin_sqrtf(fmaxf(1.0f - a * a, 0.f));
                const unsigned w = uu[i][j >> 1]; const float u = ((j & 1) ? __uint_as_float(w & 0xffff0000u) : __uint_as_float(w << 16)) * mult;
                H[j] = a * H[j] + u; P[j] *= a; }
#pragma unroll
        for (int off = 1; off < 32; off <<= 1) {
#pragma unroll
            for (int j = 0; j < 8; ++j) { const float pp = __shfl_up(P[j], 2 * off), hp = __shfl_up(H[j], 2 * off); if (cw >= off) { H[j] = P[j] * hp + H[j]; P[j] *= pp; } } }
        if (cw == 31) {
#pragma unroll
            for (int j = 0; j < 8; ++j) { sW[((wid * 2 + hf) * 8 + j) * 2] = P[j]; sW[((wid * 2 + hf) * 8 + j) * 2 + 1] = H[j]; } }
        __syncthreads();
        float h[8];
#pragma unroll
        for (int j = 0; j < 8; ++j) { float h0 = 0.f;
            for (int w = 0; w < wid; ++w) h0 = sW[((w * 2 + hf) * 8 + j) * 2] * h0 + sW[((w * 2 + hf) * 8 + j) * 2 + 1];
            float pe = __shfl_up(P[j], 2), he = __shfl_up(H[j], 2); if (cw == 0) { pe = 1.f; he = 0.f; }
            h[j] = pe * h0 + he; }
#pragma unroll
        for (int i = 0; i < 8; ++i) { float y[8];
#pragma unroll
            for (int j = 0; j < 8; ++j) { const float a = av[i][j]; const float mult = __builtin_sqrtf(fmaxf(1.0f - a * a, 0.f));
                const unsigned w = uu[i][j >> 1]; const float u = ((j & 1) ? __uint_as_float(w & 0xffff0000u) : __uint_as_float(w << 16)) * mult;
                const unsigned gw_ = gg[i][j >> 1]; const float g = (j & 1) ? __uint_as_float(gw_ & 0xffff0000u) : __uint_as_float(gw_ << 16);
                h[j] = a * h[j] + u; y[j] = h[j] * g; }
            u32x4 o; o.x = pk_bf16(y[0], y[1]); o.y = pk_bf16(y[2], y[3]); o.z = pk_bf16(y[4], y[5]); o.w = pk_bf16(y[6], y[7]);
            *(u32x4*)(Y + base + (size_t)i * D) = o; }
        __syncthreads();
    }
}
__device__ __forceinline__ float log_sigmoid_f(float x) { return fminf(x, 0.f) - log1pf(expf(-fabsf(x))); }
__device__ __forceinline__ void kmax_pass(const bf16* K, unsigned* KM2, int wid, int lane) {
    for (int task = blockIdx.x * NWAVES + wid; task < NB * NH * 16; task += gridDim.x * NWAVES) {
        const int bh = task >> 4, chunk = task & 15, b = bh >> 4, h = bh & 15; float best = 0.f;
#pragma unroll
        for (int kk = 0; kk < 2; ++kk) { const bf16* kp = K + ((size_t)b * SEQ + chunk * 128 + lane * 2 + kk) * D + h * 64; float s = 0.f;
#pragma unroll
            for (int j = 0; j < 8; ++j) { const u32x4 w = *(const u32x4*)(kp + j * 8);
#pragma unroll
                for (int e = 0; e < 4; ++e) { const float lo = __uint_as_float(w[e] << 16), hi_ = __uint_as_float(w[e] & 0xffff0000u); s += lo * lo + hi_ * hi_; } }
            best = fmaxf(best, s); }
#pragma unroll
        for (int o = 1; o < 64; o <<= 1) best = fmaxf(best, __shfl_xor(best, o));
        if (lane == 0) atomicMax(KM2 + bh, __float_as_uint(best));
    }
}
__device__ __forceinline__ void cphase(const float* FL, float* C2, int wid, int lane) {
    for (int gw = blockIdx.x * NWAVES + wid; gw < NB * NH; gw += gridDim.x * NWAVES) {
        const int b = gw >> 4, h = gw & 15; const float* src = FL + ((size_t)b * SEQ + lane * 32) * 16 + h;
        float v[32];
#pragma unroll
        for (int i = 0; i < 32; ++i) v[i] = src[i * 16];
        float s = 0.f;
#pragma unroll
        for (int i = 0; i < 32; ++i) { s += log_sigmoid_f(v[i]); v[i] = s; }
        float inc = s;
#pragma unroll
        for (int o = 1; o < 64; o <<= 1) { const float t = __shfl_up(inc, o); if (lane >= o) inc += t; }
        const float carry = inc - s; f32x4* dst = (f32x4*)(C2 + (size_t)gw * SEQ + lane * 32);
#pragma unroll
        for (int i = 0; i < 8; ++i) dst[i] = (f32x4){(v[4 * i] + carry) * -1.4426950408889634f, (v[4 * i + 1] + carry) * -1.4426950408889634f, (v[4 * i + 2] + carry) * -1.4426950408889634f, (v[4 * i + 3] + carry) * -1.4426950408889634f};
    }
}
__device__ __forceinline__ void f_phase(const bf16* HB, const float* SSQ, const bf16* Wf, const float* bfg, float* FL, LAS unsigned char* lds, int tid) {
    const int lane = tid & 63, wid = tid >> 6, r32 = lane & 31, hi = lane >> 5, kq = wid & 3, tsel = wid >> 2;
    LAS float* red = (LAS float*)lds;
    for (int t2 = blockIdx.x; t2 < M / 64; t2 += gridDim.x) {
        const int tok0 = (2 * t2 + tsel) * 32;
        const bf16* ap = HB + (size_t)(tok0 + r32) * D + kq * 256 + hi * 8; const bf16* bp = Wf + (size_t)r32 * D + kq * 256 + hi * 8;
        f32x16 acc;
#pragma unroll
        for (int r = 0; r < 16; ++r) acc[r] = 0.f;
#pragma unroll
        for (int k0 = 0; k0 < 256; k0 += 16) { const bf16x8 av = *(const bf16x8*)(ap + k0), bv = *(const bf16x8*)(bp + k0); acc = __builtin_amdgcn_mfma_f32_32x32x16_bf16(av, bv, acc, 0, 0, 0); }
#pragma unroll
        for (int r = 0; r < 16; ++r) red[((tsel * 4 + kq) * 16 + r) * 64 + lane] = acc[r];
        __syncthreads();
        if (kq == 0 && r32 < 16) { const float bias = bfg[r32];
#pragma unroll
            for (int r = 0; r < 16; ++r) { const int tok = tok0 + (r & 3) + 8 * (r >> 2) + 4 * hi; const f32x4* p = (const f32x4*)(SSQ + (size_t)tok * 16);
                const f32x4 s4 = (p[0] + p[1]) + (p[2] + p[3]); const float rinv = __builtin_amdgcn_rsqf(((s4[0] + s4[1]) + (s4[2] + s4[3])) * (1.0f / D) + 1e-6f);
                const float v = (red[((tsel * 4 + 0) * 16 + r) * 64 + lane] + red[((tsel * 4 + 1) * 16 + r) * 64 + lane]) + (red[((tsel * 4 + 2) * 16 + r) * 64 + lane] + red[((tsel * 4 + 3) * 16 + r) * 64 + lane]);
                FL[(size_t)tok * 16 + r32] = v * rinv + bias; } }
        __syncthreads();
    }
}
namespace att {
constexpr int RS = 144, TB = 64 * RS;
constexpr int OFF_K = 0, OFF_V = 2 * TB, OFF_C = 4 * TB;
__device__ __forceinline__ void attn_unit(int b, int h, int qb, const bf16* Q, const bf16* K, const bf16* VT, const float* C2, const unsigned* KM2, bf16* O, LAS unsigned char* lds, int tid) {
    const int lane = tid & 63, wid = __builtin_amdgcn_readfirstlane(tid >> 6), r32 = lane & 31, hi = lane >> 5;
    const int q0 = qb * 256, qw0 = q0 + wid * 32, q = qw0 + r32; const size_t rowbase = (size_t)b * SEQ;
    bf16x8 qf[4]; { const bf16* qp = Q + (rowbase + q) * D + h * 64 + hi * 8;
#pragma unroll
        for (int d0 = 0; d0 < 4; ++d0) qf[d0] = *(const bf16x8*)(qp + d0 * 16); }
    const float* cb = C2 + (size_t)(b * NH + h) * SEQ;
    float qn2 = 0.f;
#pragma unroll
    for (int d0 = 0; d0 < 4; ++d0)
#pragma unroll
        for (int e = 0; e < 8; ++e) { const float v = __uint_as_float((unsigned)(unsigned short)qf[d0][e] << 16); qn2 += v * v; }
    qn2 += __shfl_xor(qn2, 32);
    const float ubase = sqrtf(qn2 * __uint_as_float(KM2[b * NH + h])) * 1.0001f;
    LAS unsigned* votes = (LAS unsigned*)(lds + 131072 + 8192 + 192);
    const int NT = (q0 + 256) / 64;
    const int srow = tid >> 3, sch = tid & 7;
    const bf16* kg = K + (rowbase + srow) * D + h * 64 + sch * 8;
    const bf16* vg = VT + ((size_t)(b * NH + h) * 64 + srow) * SEQ + sch * 8;
    const int soff = srow * RS + sch * 16;
    int ckey = 0; { const int r = tid & 15, hh = (tid >> 4) & 1, half = (tid >> 5) & 1; const int rho = (r & 3) + 8 * (r >> 2) + 4 * hh; ckey = 32 * half + ((rho & ~12) | ((rho & 4) << 1) | ((rho & 8) >> 1)); }
    const int krow = (r32 & ~12) | ((r32 & 4) << 1) | ((r32 & 8) >> 1);
    f32x16 o0, o1;
#pragma unroll
    for (int r = 0; r < 16; ++r) { o0[r] = 0.f; o1[r] = 0.f; }
    float mrun = -1e30f, lrun = 0.f;
    u32x4 kr = *(const u32x4*)(kg + (size_t)(NT - 1) * 64 * D), vr = *(const u32x4*)(vg + (NT - 1) * 64); float cr = (tid < 64) ? cb[(NT - 1) * 64 + ckey] : 0.f;
    *(LAS u32x4*)(lds + OFF_K + soff) = kr; *(LAS u32x4*)(lds + OFF_V + soff) = vr; if (tid < 64) *(LAS float*)(lds + OFF_C + tid * 4) = cr;
    kr = *(const u32x4*)(kg + (size_t)(NT - 2) * 64 * D); vr = *(const u32x4*)(vg + (NT - 2) * 64); if (tid < 64) cr = cb[(NT - 2) * 64 + ckey];
    __syncthreads();
    for (int it = 0; it < NT; ++it) {
        const int t = NT - 1 - it; const int cur = it & 1; const bool more = (t > 0);
        const bool active = (64 * t <= qw0 + 31);
        f32x16 s0, s1; bf16x8 v00, v01, v02, v03, v10, v11, v12, v13;
        if (active) {
            const LAS unsigned char* kb = lds + OFF_K + cur * TB; const LAS float* cs = (const LAS float*)(lds + OFF_C + cur * 256);
#pragma unroll
            for (int i = 0; i < 4; ++i) { const f32x4 c0 = *(const LAS f32x4*)(cs + hi * 16 + 4 * i), c1 = *(const LAS f32x4*)(cs + 32 + hi * 16 + 4 * i);
#pragma unroll
                for (int j = 0; j < 4; ++j) { s0[4 * i + j] = c0[j]; s1[4 * i + j] = c1[j]; } }
            const LAS unsigned char* ka = kb + krow * RS + hi * 16;
#pragma unroll
            for (int d0 = 0; d0 < 4; ++d0) { const bf16x8 k0 = *(const LAS bf16x8*)(ka + d0 * 32), k1 = *(const LAS bf16x8*)(ka + 32 * RS + d0 * 32);
                s0 = __builtin_amdgcn_mfma_f32_32x32x16_bf16(k0, qf[d0], s0, 0, 0, 0); s1 = __builtin_amdgcn_mfma_f32_32x32x16_bf16(k1, qf[d0], s1, 0, 0, 0); }
            { const LAS unsigned char* va = lds + OFF_V + cur * TB + r32 * RS + hi * 16;
              v00 = *(const LAS bf16x8*)(va); v01 = *(const LAS bf16x8*)(va + 32); v02 = *(const LAS bf16x8*)(va + 64); v03 = *(const LAS bf16x8*)(va + 96);
              v10 = *(const LAS bf16x8*)(va + 32 * RS); v11 = *(const LAS bf16x8*)(va + 32 * RS + 32); v12 = *(const LAS bf16x8*)(va + 32 * RS + 64); v13 = *(const LAS bf16x8*)(va + 32 * RS + 96); }
        }
        if (more) { const int nb = cur ^ 1; *(LAS u32x4*)(lds + OFF_K + nb * TB + soff) = kr; *(LAS u32x4*)(lds + OFF_V + nb * TB + soff) = vr; if (tid < 64) *(LAS float*)(lds + OFF_C + nb * 256 + tid * 4) = cr; }
        if (t > 1) { kr = *(const u32x4*)(kg + (size_t)(t - 2) * 64 * D); vr = *(const u32x4*)(vg + (t - 2) * 64); if (tid < 64) cr = cb[(t - 2) * 64 + ckey]; }
        if (active) {
            if (64 * t + 63 > qw0) {
#pragma unroll
                for (int r = 0; r < 16; ++r) { const int key = 64 * t + 16 * (r >> 3) + 8 * hi + (r & 7); if (key > q) s0[r] = -1e30f; if (key + 32 > q) s1[r] = -1e30f; } }
#define MX3(a_, b_, c_) __builtin_fmaxf(__builtin_fmaxf((a_), (b_)), (c_))
            float mxa = MX3(s0[0], s0[1], s1[0]), mxb = MX3(s0[2], s0[3], s1[1]); mxa = MX3(mxa, s1[2], s1[3]);
#pragma unroll
            for (int r = 4; r < 16; r += 4) { mxa = MX3(mxa, s0[r], s0[r + 1]); mxb = MX3(mxb, s0[r + 2], s0[r + 3]); mxa = MX3(mxa, s1[r], s1[r + 1]); mxb = MX3(mxb, s1[r + 2], s1[r + 3]); }
            float mx = __builtin_fmaxf(mxa, mxb);
#undef MX3
            { const auto sw = __builtin_amdgcn_permlane32_swap(__float_as_uint(mx), __float_as_uint(mx), false, false);
              mx = __builtin_fmaxf(__uint_as_float(sw[0]), __uint_as_float(sw[1])); }
            if (__any(mx > mrun - 40.0f)) {
            const float mnew = fmaxf(mrun, mx); const float alpha = __builtin_amdgcn_exp2f(mrun - mnew); mrun = mnew;
            if (__any(alpha != 1.0f)) {
#pragma unroll
                for (int r = 0; r < 16; ++r) { o0[r] *= alpha; o1[r] *= alpha; } }
            float rs = 0.f;
#define PV_GROUP(SV, B0, VA, VB) { float e_[8]; \
                _Pragma("unroll") for (int j = 0; j < 8; ++j) { e_[j] = __builtin_amdgcn_exp2f(SV[(B0) + j] - mnew); rs += e_[j]; } \
                u32x4 pw_; pw_.x = pk_bf16(e_[0], e_[1]); pw_.y = pk_bf16(e_[2], e_[3]); pw_.z = pk_bf16(e_[4], e_[5]); pw_.w = pk_bf16(e_[6], e_[7]); \
                const bf16x8 pp_ = __builtin_bit_cast(bf16x8, pw_); \
                o0 = __builtin_amdgcn_mfma_f32_32x32x16_bf16(VA, pp_, o0, 0, 0, 0); o1 = __builtin_amdgcn_mfma_f32_32x32x16_bf16(VB, pp_, o1, 0, 0, 0); \
                __builtin_amdgcn_sched_barrier(0); }
            PV_GROUP(s0, 0, v00, v10) PV_GROUP(s0, 8, v01, v11) PV_GROUP(s1, 0, v02, v12) PV_GROUP(s1, 8, v03, v13)
#undef PV_GROUP
            lrun = lrun * alpha + rs;
            }
        }
        { bool ok = false;
          if (more && 64 * t <= qw0 + 31) ok = __all(ubase + cb[64 * t - 1] < mrun - 40.0f);
          if (lane == 0) votes[(it & 1) * 8 + wid] = ok ? 1u : 0u; }
        __syncthreads();
        if (more) { const LAS unsigned* vv = votes + (it & 1) * 8; if ((vv[0] & vv[1] & vv[2] & vv[3] & vv[4] & vv[5] & vv[6] & vv[7]) != 0u) break; }
    }
    const float lt = lrun + __shfl_xor(lrun, 32); const float il = 1.0f / lt;
    bf16* op = O + (rowbase + q) * D + h * 64 + 4 * hi;
#pragma unroll
    for (int g = 0; g < 4; ++g) { u32x2 w0, w1;
        w0.x = pk_bf16(o0[4 * g] * il, o0[4 * g + 1] * il); w0.y = pk_bf16(o0[4 * g + 2] * il, o0[4 * g + 3] * il);
        w1.x = pk_bf16(o1[4 * g] * il, o1[4 * g + 1] * il); w1.y = pk_bf16(o1[4 * g + 2] * il, o1[4 * g + 3] * il);
        *(u32x2*)(op + 8 * g) = w0; *(u32x2*)(op + 32 + 8 * g) = w1; }
}
__device__ __forceinline__ void attn_phase(const bf16* Q, const bf16* K, const bf16* VT, const float* C2, const unsigned* KM2, bf16* O, LAS unsigned char* lds, int tid, unsigned* ctr) {
    LAS unsigned* slot = (LAS unsigned*)(lds + 131072 + 8192 + 128);
    for (;;) {
        if (tid == 0) *slot = __hip_atomic_fetch_add(ctr, 1u, __ATOMIC_RELAXED, __HIP_MEMORY_SCOPE_AGENT);
        __syncthreads();
        const int pu = (int)*slot;
        __syncthreads();
        if (pu >= NB * NH * 8) break;
        const int h = 15 - (pu >> 6), qb = 7 - ((pu >> 3) & 7), b = pu & 7;
        attn_unit(b, h, qb, Q, K, VT, C2, KM2, O, lds, tid);
    }
}
}

#ifndef REP_PRO
#define REP_PRO 1
#endif
#ifndef REP_CONV
#define REP_CONV 1
#endif
#ifndef REP_SCAN
#define REP_SCAN 1
#endif
#ifndef REP_ATT
#define REP_ATT 1
#endif
#ifndef REP_FFNIN
#define REP_FFNIN 1
#endif
#ifndef REP_INPROJ
#define REP_INPROJ 1
#endif
#ifndef REP_GATES
#define REP_GATES 1
#endif
#ifndef REP_QKVF
#define REP_QKVF 1
#endif
__global__ void __launch_bounds__(NTHREADS, 2) fwd_megakernel(Args a) {
    extern __shared__ __attribute__((aligned(16))) unsigned char lds_raw[];
    LAS unsigned char* lds = (LAS unsigned char*)lds_raw;
    const int tid = threadIdx.x, lane = tid & 63, wid = __builtin_amdgcn_readfirstlane(tid >> 6);
    const int G = gridDim.x, bx = blockIdx.x;
    unsigned char* ws = a.ws;
    bf16* HB = (bf16*)(ws + WS_HB); float* SSQ = (float*)(ws + WS_SSQ); float* FL = (float*)(ws + WS_FL); float* C2 = (float*)(ws + WS_C2);
    bf16* X0 = (bf16*)(ws + WS_X0); bf16* X1 = (bf16*)(ws + WS_X1); bf16* X2 = (bf16*)(ws + WS_X2);
    bf16* ZA = (bf16*)(ws + WS_Z); bf16* ZU = (bf16*)(ws + WS_ZU); bf16* ACT = (bf16*)(ws + WS_Z);
    const int gw = bx * NWAVES + wid, NGW = G * NWAVES;
    float* SP8 = (float*)ws;
    LAS float* RT = (LAS float*)(lds + 131072);

    if (tid < 4) ((LAS unsigned*)(lds + 131072 + 8192 + 64))[tid] = 0u;
    __syncthreads();
    {
        LAS float* scr = (LAS float*)(lds + wid * 16384);
        for (int rep = 0; rep < REP_PRO; ++rep)
        for (int it = gw; it < a.total_items; it += NGW) {
            int di = 0;
#pragma unroll 1
            for (int j = 1; j < NCD; ++j) if (it >= a.cd[j].start) di = j;
            convert_item(a.cd[di], it - a.cd[di].start, scr, lane);
        }
        for (int i = bx * NTHREADS + tid; i < 2 * D; i += G * NTHREADS) { const float z = -a.in[10][i]; SP8[i] = -8.0f * (fmaxf(z, 0.f) + log1pf(expf(-fabsf(z)))); }
        const float* x = a.in[0];
        for (int rep = 0; rep < REP_PRO; ++rep)
        for (int m0 = gw; m0 < M; m0 += 4 * NGW) {
            f32x4 v[4][4];
#pragma unroll
            for (int r = 0; r < 4; ++r) { const int m = m0 + r * NGW; if (m < M) { const f32x4* xr = (const f32x4*)(x + (size_t)m * D) + lane;
#pragma unroll
                for (int j = 0; j < 4; ++j) v[r][j] = xr[64 * j]; } }
#pragma unroll
            for (int r = 0; r < 4; ++r) { const int m = m0 + r * NGW; if (m < M) { u32x2* hb = (u32x2*)(HB + (size_t)m * D) + lane; float s = 0.f;
#pragma unroll
                for (int j = 0; j < 4; ++j) { const f32x4 q = v[r][j]; s += (q[0] * q[0] + q[1] * q[1]) + (q[2] * q[2] + q[3] * q[3]); u32x2 w; w.x = pk_bf16(q[0], q[1]); w.y = pk_bf16(q[2], q[3]); hb[64 * j] = w; }
                s = wave_sum(s);
                if (lane < 16) SSQ[(size_t)m * 16 + lane] = (lane == 0) ? s : 0.f; } }
        }
    }
    const XcdBarrier xbar = xcd_barrier_post((unsigned*)(ws + WS_BAR), (volatile LAS unsigned*)(lds + 131072 + 8192 + 64));
#define GSYNC() do { XcdBarrier xb_ = xbar; asm volatile("" : "+s"(xb_.x)); xcd_barrier(xb_); } while (0)
    GSYNC();

    for (int l = 0; l < 4; ++l) {
        const bf16* mixA; const bf16* mixB;
        if (l < 2) {
#ifndef SKIP_INPROJ
            for (int rep = 0; rep < REP_INPROJ; ++rep) { pg8::Gemm g{HB, (const bf16*)(ws + WS_WRECIN) + (size_t)l * 2048 * D, M, 2048, D}; pg8::IdxOrder S; S.S.init(M, 2048, G, bx); S.ssq = SSQ; S.rt = RT;
              pg8::EpiInProj E{RT, X0, X1};
              pg8::gemm_phase<pg8::EpiInProj, pg8::IdxOrder, true, true>(lds, g, S, E); }
#endif
            GSYNC();
#ifndef SKIP_CONV
            for (int rep = 0; rep < REP_CONV; ++rep) { int tl = tid; asm volatile("" : "+v"(tl)); conv_phase(X1, a.in[6] + (size_t)l * 4 * D, a.in[7] + (size_t)l * D, X2, tl); }
#endif
            GSYNC();
#ifndef SKIP_GATES
            for (int rep = 0; rep < REP_GATES; ++rep) { int kg = 256; asm volatile("" : "+s"(kg)); pg8::Gemm g{X2, (const bf16*)(ws + WS_WGATES) + (size_t)l * 2048 * 256, 4 * M, 2048, kg}; pg8::GatesOrder S{G, bx};
              pg8::EpiGates E{X2, a.in[9] + (size_t)l * 2048, SP8 + (size_t)l * D, ZA, ZU};
              pg8::gemm_phase<pg8::EpiGates, pg8::GatesOrder, true, true>(lds, g, S, E); }
#endif
            GSYNC();
#ifndef SKIP_SCAN
            for (int rep = 0; rep < REP_SCAN; ++rep) { int tl = tid; asm volatile("" : "+v"(tl)); scan_phase(ZA, ZU, X0, X1, lds, tl); }
#endif
            mixA = X1; mixB = (const bf16*)(ws + WS_WRECOUT) + (size_t)l * D * D;
        } else {
#ifndef SKIP_QKVF
            if (l == 2) { int tl = tid; asm volatile("" : "+v"(tl)); f_phase(HB, SSQ, (const bf16*)(ws + WS_WQKVF) + (size_t)3072 * D, a.in[14], FL, lds, tl); }
            for (int rep = 0; rep < REP_QKVF; ++rep) { const bool first = (l == 2); const int N = first ? 3072 : D;
              pg8::Gemm g{HB, first ? (const bf16*)(ws + WS_WQKVF) : (const bf16*)(ws + WS_WQ1), M, N, D}; pg8::IdxOrder S; S.S.init(M, N, G, bx); S.ssq = SSQ; S.rt = RT;
              pg8::EpiQkvf E{RT, X0, X1, X2, FL, a.in[14]};
              pg8::gemm_phase<pg8::EpiQkvf, pg8::IdxOrder, true, true>(lds, g, S, E); }
#endif
            GSYNC();
            if (l == 2) { int tl = tid; asm volatile("" : "+v"(tl)); cphase(FL, C2, tl >> 6, tl & 63); kmax_pass(X1, (unsigned*)(ws + WS_BAR + 16384 + 1024), tl >> 6, tl & 63); GSYNC(); }
#ifndef SKIP_ATT
            for (int rep = 0; rep < REP_ATT; ++rep) { int tl = tid; asm volatile("" : "+v"(tl)); att::attn_phase(X0, X1, X2, C2, (const unsigned*)(ws + WS_BAR + 16384 + 1024), ACT, lds, tl, (unsigned*)(ws + WS_BAR + 16384) + (l - 2) * 64); }
#endif
            mixA = ACT; mixB = (const bf16*)(ws + WS_WO) + (size_t)(l - 2) * D * D;
        }
        GSYNC();
#ifndef SKIP_RES1
        { pg8::Gemm g{mixA, mixB, M, D, D}; pg8::StaticOrder S; S.init(M, D, G, bx);
          pg8::EpiRes E{HB, SSQ};
          pg8::gemm_phase<pg8::EpiRes, pg8::StaticOrder, true, true>(lds, g, S, E); }
#endif
        GSYNC();
#ifndef SKIP_FFNIN
        for (int rep = 0; rep < REP_FFNIN; ++rep) { pg8::Gemm g{HB, (const bf16*)(ws + WS_WFFNIN) + (size_t)l * 2 * FF * D, M, 2 * FF, D}; pg8::IdxOrder S; S.S.init(M, 2 * FF, G, bx); S.ssq = SSQ; S.rt = RT;
          pg8::EpiFfnIn E{RT, ACT};
          pg8::gemm_phase<pg8::EpiFfnIn, pg8::IdxOrder, true, true>(lds, g, S, E); }
#endif
        GSYNC();
#ifndef SKIP_RES2
        { pg8::Gemm g{ACT, (const bf16*)(ws + WS_WFFNOUT) + (size_t)l * D * FF, M, D, FF}; pg8::StaticOrder S; S.init(M, D, G, bx);
          pg8::EpiRes E{HB, SSQ};
          pg8::gemm_phase<pg8::EpiRes, pg8::StaticOrder, true, true>(lds, g, S, E); }
#endif
        GSYNC();
    }
    {
        const float* gn = a.in[17]; int tl = tid; asm volatile("" : "+v"(tl)); const int lane = tl & 63; const int gw = bx * NWAVES + (tl >> 6);
        for (int m0 = gw; m0 < M; m0 += 4 * NGW) {
            u32x4 w[4][2];
#pragma unroll
            for (int r = 0; r < 4; ++r) { const int m = m0 + r * NGW; if (m < M) { const u32x4* hr = (const u32x4*)(HB + (size_t)m * D) + lane; w[r][0] = hr[0]; w[r][1] = hr[64]; } }
#pragma unroll
            for (int r = 0; r < 4; ++r) { const int m = m0 + r * NGW; if (m < M) { float* orow = a.out + (size_t)m * D; float v[16]; float s = 0.f;
#pragma unroll
                for (int j = 0; j < 2; ++j)
#pragma unroll
                    for (int e = 0; e < 4; ++e) { v[8 * j + 2 * e] = __uint_as_float(w[r][j][e] << 16); v[8 * j + 2 * e + 1] = __uint_as_float(w[r][j][e] & 0xffff0000u); }
#pragma unroll
                for (int e = 0; e < 16; ++e) s += v[e] * v[e];
                const float rn = 1.0f / sqrtf(wave_sum(s) * (1.0f / D) + 1e-6f);
#pragma unroll
                for (int j = 0; j < 2; ++j) { const int c0 = 512 * j + 8 * lane; const f32x4 g0 = *(const f32x4*)(gn + c0), g1 = *(const f32x4*)(gn + c0 + 4);
                    *(f32x4*)(orow + c0) = (f32x4){v[8 * j] * rn * g0[0], v[8 * j + 1] * rn * g0[1], v[8 * j + 2] * rn * g0[2], v[8 * j + 3] * rn * g0[3]};
                    *(f32x4*)(orow + c0 + 4) = (f32x4){v[8 * j + 4] * rn * g1[0], v[8 * j + 5] * rn * g1[1], v[8 * j + 6] * rn * g1[2], v[8 * j + 7] * rn * g1[3]}; } } }
        }
    }
}

extern "C" void kernel_launch(void* const* d_in, const int* in_sizes, int n_in, void* d_out, int out_size, void* d_ws, size_t ws_size, hipStream_t stream) {
    static int grid = 0;
    if (grid == 0) {
        if (n_in != 18 || in_sizes[0] != M * D || out_size != M * D || ws_size < WS_END) { fprintf(stderr, "kernel_launch: unexpected shapes (n_in %d, in0 %d, out %d, ws %zu < %zu); nothing launched\n", n_in, n_in > 0 ? in_sizes[0] : -1, out_size, ws_size, (size_t)WS_END); grid = -1; return; }
        int dev = 0, cus = 0, per_cu = 0;
        if (hipGetDevice(&dev) != hipSuccess || hipDeviceGetAttribute(&cus, hipDeviceAttributeMultiprocessorCount, dev) != hipSuccess) { grid = -1; return; }
        if (hipFuncSetAttribute((const void*)fwd_megakernel, hipFuncAttributeMaxDynamicSharedMemorySize, LDS_BYTES) != hipSuccess) { fprintf(stderr, "kernel_launch: hipFuncSetAttribute failed\n"); grid = -1; return; }
        if (hipOccupancyMaxActiveBlocksPerMultiprocessor(&per_cu, (const void*)fwd_megakernel, NTHREADS, LDS_BYTES) != hipSuccess || per_cu < 1) { fprintf(stderr, "kernel_launch: occupancy query failed (%d)\n", per_cu); (void)hipGetLastError(); grid = -1; return; }
        grid = cus * (per_cu > 1 ? 1 : per_cu);
        if (grid < 176) { fprintf(stderr, "kernel_launch: %d CUs: the per-unit 1/rms LDS table is sized for >= 176 workgroups; nothing launched\n", grid); grid = -1; return; }
    }
    if (grid < 0) return;
    Args a{};
    for (int i = 0; i < 18; ++i) a.in[i] = (const float*)d_in[i];
    a.out = (float*)d_out; a.ws = (unsigned char*)d_ws;
    unsigned char* ws = (unsigned char*)d_ws;
    const float* norm_mix = a.in[1]; const float* norm_ffn = a.in[2]; const float* w_ffn_in = a.in[3]; const float* w_ffn_out = a.in[4]; const float* w_rec_in = a.in[5];
    const float* w_lru = a.in[8]; const float* w_rec_out = a.in[11]; const float* norm_kv = a.in[12]; const float* w_kvf = a.in[13]; const float* w_q = a.in[15]; const float* w_o = a.in[16];
    int n = 0, start = 0;
    auto add = [&](const float* W, const float* gain, bf16* WT, int ldw, int K, int groups, int half, int nvalid) {
        ConvDesc& d = a.cd[n++]; d.W = W; d.gain = gain; d.WT = WT; d.ldw = ldw; d.K = K; d.groups = groups; d.half = half; d.nvalid = nvalid; d.start = start; start += (K / 64) * groups; };
    for (int l = 0; l < 4; ++l) add(w_ffn_in + (size_t)l * D * 2 * FF, norm_ffn + l * D, (bf16*)(ws + WS_WFFNIN) + (size_t)l * 2 * FF * D, 2 * FF, D, 2 * FF / 32, FF, 2 * FF);
    for (int l = 0; l < 4; ++l) add(w_ffn_out + (size_t)l * FF * D, nullptr, (bf16*)(ws + WS_WFFNOUT) + (size_t)l * D * FF, D, FF, D / 32, 0, D);
    for (int i = 0; i < 2; ++i) add(w_rec_in + (size_t)i * D * 2048, norm_mix + i * D, (bf16*)(ws + WS_WRECIN) + (size_t)i * 2048 * D, 2048, D, 64, 0, 2048);
    for (int i = 0; i < 8; ++i) add(w_lru + (size_t)i * 256 * 512, nullptr, (bf16*)(ws + WS_WGATES) + (size_t)i * 512 * 256, 512, 256, 16, 256, 512);
    for (int i = 0; i < 2; ++i) add(w_rec_out + (size_t)i * D * D, nullptr, (bf16*)(ws + WS_WRECOUT) + (size_t)i * D * D, D, D, 32, 0, D);
    add(w_q, norm_mix + 2 * D, (bf16*)(ws + WS_WQKVF), D, D, 32, 0, D);
    add(w_kvf, norm_kv, (bf16*)(ws + WS_WQKVF) + (size_t)D * D, 2064, D, (3104 - D) / 32, 0, 2064);
    add(w_q + (size_t)D * D, norm_mix + 3 * D, (bf16*)(ws + WS_WQ1), D, D, 32, 0, D);
    for (int j = 0; j < 2; ++j) add(w_o + (size_t)j * D * D, nullptr, (bf16*)(ws + WS_WO) + (size_t)j * D * D, D, D, 32, 0, D);
    a.total_items = start; a.pad = 0;
    if (n != NCD) { fprintf(stderr, "kernel_launch: descriptor count %d != %d\n", n, NCD); return; }
    if (hipMemsetAsync((unsigned char*)d_ws + WS_BAR, 0, 16384 + 2048, stream) != hipSuccess) { fprintf(stderr, "kernel_launch: hipMemsetAsync of the barrier words failed; nothing launched\n"); return; }
    void* args[] = {&a};
    hipError_t e = hipLaunchCooperativeKernel((const void*)fwd_megakernel, dim3(grid), dim3(NTHREADS), args, LDS_BYTES, stream);
    if (e != hipSuccess) fprintf(stderr, "kernel_launch: cooperative launch failed: %s (grid %d)\n", hipGetErrorString(e), grid);
}
```
